# Optimizing an MI355X kernel written in HIP

```python
import jax, jax.numpy as jnp
from jax import lax
import numpy as np

D_MODEL = 1024
BATCH = 2
SEQ = 8192
DEPTH = 2

HGRN_WIDTH = D_MODEL
HGRN_HEADS = 8
HGRN_EXPAND = HGRN_WIDTH // HGRN_HEADS
HGRN_HEAD_V = HGRN_WIDTH // HGRN_HEADS
HGRN_FDIM = HGRN_HEADS * HGRN_EXPAND
GLA_HEADS = 4
GLA_KEY = D_MODEL // 2
GLA_VAL = D_MODEL
GLA_HEAD_K = GLA_KEY // GLA_HEADS
GLA_HEAD_V = GLA_VAL // GLA_HEADS
GLA_GATE_RANK = 16
GLA_GATE_TAU = 16.0
N_BRANCH = 2
CHUNK = 64
EPS = 1e-6
F_FLOOR = 1e-20
IN_SPLITS = (HGRN_FDIM, HGRN_FDIM, HGRN_WIDTH, HGRN_WIDTH,
             GLA_KEY, GLA_KEY, GLA_VAL, GLA_VAL,
             GLA_GATE_RANK,
             N_BRANCH * D_MODEL)
D_IN = sum(IN_SPLITS)
IN_OFFSETS = tuple(int(v) for v in np.cumsum(IN_SPLITS)[:-1])

kernel_name = "hybrid_hgrn2_gla_adaln"


def rms_norm(x, w):
    xf = x.astype(jnp.float32)
    y = xf * lax.rsqrt(jnp.mean(xf * xf, axis=-1, keepdims=True) + EPS)
    return (y * w.astype(jnp.float32)).astype(x.dtype)


def chunked_gated_linear_attention(q, k, v, log_a, scale):
    B, T, H, K = q.shape
    V = v.shape[-1]
    n = T // CHUNK
    f32 = jnp.float32

    def to_chunks(t):
        return t.astype(f32).reshape(B, n, CHUNK, H, t.shape[-1]).transpose(1, 0, 3, 2, 4)

    qc, kc, vc, gc = to_chunks(q * scale), to_chunks(k), to_chunks(v), to_chunks(log_a)
    causal = jnp.tril(jnp.ones((CHUNK, CHUNK), dtype=bool))[:, :, None]

    def step(S, inp):
        qi, ki, vi, gi = inp
        b = jnp.cumsum(gi, axis=2)
        o_inter = jnp.einsum('bhck,bhkv->bhcv', qi * jnp.exp(b), S)
        diff = b[:, :, :, None, :] - b[:, :, None, :, :]
        decay = jnp.where(causal, jnp.exp(jnp.minimum(diff, 0.0)), 0.0)
        scores = jnp.einsum('bhtk,bhsk,bhtsk->bhts', qi, ki, decay)
        o_intra = jnp.einsum('bhts,bhsv->bhtv', scores, vi)
        b_last = b[:, :, -1:, :]
        S_new = S * jnp.exp(b_last[:, :, 0, :])[..., None] + jnp.einsum(
            'bhsk,bhsv->bhkv', ki * jnp.exp(b_last - b), vi)
        return S_new, o_inter + o_intra

    S0 = jnp.zeros((B, H, K, V), f32)
    _, o = lax.scan(step, S0, (qc, kc, vc, gc))
    return o.transpose(1, 0, 3, 2, 4).reshape(B, T, H, V).astype(v.dtype)


def hgrn2_branch(hq, hf, hi, hz, lb, norm_w):
    B, T, _ = hq.shape
    q = jax.nn.silu(hq).reshape(B, T, HGRN_HEADS, HGRN_EXPAND)
    fr = hf.astype(jnp.float32).reshape(B, T, HGRN_HEADS, HGRN_EXPAND)
    lb = jnp.clip(lb.astype(jnp.float32), 0.0, 1.0).reshape(HGRN_HEADS, HGRN_EXPAND)
    f = lb + (1.0 - lb) * jax.nn.sigmoid(fr)
    log_f = jnp.log(jnp.maximum(f, F_FLOOR))
    k = (1.0 - lb) * jax.nn.sigmoid(-fr)
    v = hi.reshape(B, T, HGRN_HEADS, HGRN_HEAD_V)
    o = chunked_gated_linear_attention(q, k, v, log_f, 1.0)
    o = rms_norm(o.reshape(B, T, HGRN_WIDTH), norm_w)
    return o * jax.nn.silu(hz)


def gla_branch(gq, gk, gv, gz, ga, alpha_w, alpha_b, norm_w):
    B, T, _ = gq.shape
    q = gq.reshape(B, T, GLA_HEADS, GLA_HEAD_K)
    k = gk.reshape(B, T, GLA_HEADS, GLA_HEAD_K)
    v = gv.reshape(B, T, GLA_HEADS, GLA_HEAD_V)
    log_a = jax.nn.log_sigmoid((ga @ alpha_w + alpha_b).astype(jnp.float32)) / GLA_GATE_TAU
    log_a = log_a.reshape(B, T, GLA_HEADS, GLA_HEAD_K)
    o = chunked_gated_linear_attention(q, k, v, log_a, GLA_HEAD_K ** -0.5)
    o = rms_norm(o, norm_w)
    return o.reshape(B, T, GLA_VAL) * jax.nn.silu(gz)


def setup_inputs(seed: int = 0) -> dict:
    key = jax.random.key(seed)
    ks = jax.random.split(key, 16)
    f32 = jnp.float32
    nrm = lambda k, shape, s: jax.random.normal(k, shape, f32) * s
    return {
        "x": nrm(ks[0], (BATCH, SEQ, D_MODEL), 1.0),
        "c": nrm(ks[1], (BATCH, D_MODEL), 1.0),
        "ada_w": nrm(ks[2], (DEPTH, D_MODEL, 3 * D_MODEL), 0.5 * D_MODEL ** -0.5),
        "ada_b": nrm(ks[3], (DEPTH, 3 * D_MODEL), 0.01),
        "norm_w": 1.0 + nrm(ks[4], (DEPTH, D_MODEL), 0.02),
        "w_in": nrm(ks[5], (DEPTH, D_MODEL, D_IN), D_MODEL ** -0.5),
        "hgrn_lb_logits": nrm(ks[6], (DEPTH, HGRN_FDIM), 0.5),
        "hgrn_norm_w": 1.0 + nrm(ks[7], (DEPTH, HGRN_WIDTH), 0.02),
        "gla_alpha_w": nrm(ks[8], (DEPTH, GLA_GATE_RANK, GLA_KEY), GLA_GATE_RANK ** -0.5),
        "gla_alpha_b": nrm(ks[9], (DEPTH, GLA_KEY), 0.1),
        "gla_norm_w": 1.0 + nrm(ks[10], (DEPTH, GLA_HEAD_V), 0.02),
        "w_branch": nrm(ks[11], (DEPTH, N_BRANCH, HGRN_WIDTH, D_MODEL), HGRN_WIDTH ** -0.5),
        "w_out": nrm(ks[12], (DEPTH, D_MODEL, D_MODEL), D_MODEL ** -0.5),
        "final_norm_w": 1.0 + nrm(ks[13], (D_MODEL,), 0.02),
    }


def reference(x, c, ada_w, ada_b, norm_w, w_in, hgrn_lb_logits, hgrn_norm_w, gla_alpha_w,
              gla_alpha_b, gla_norm_w, w_branch, w_out, final_norm_w):
    B, T, _ = x.shape
    c_act = jax.nn.silu(c)
    p = jax.nn.softmax(hgrn_lb_logits.astype(jnp.float32), axis=0)
    lb_all = jnp.cumsum(p, axis=0) - p[0:1]
    for l in range(DEPTH):
        mod = c_act @ ada_w[l] + ada_b[l]
        shift, scale, gate = jnp.split(mod, 3, axis=-1)
        h = rms_norm(x, norm_w[l]) * (1.0 + scale[:, None, :]) + shift[:, None, :]
        proj = h @ w_in[l]
        hq, hf, hi, hz, gq, gk, gv, gz, ga, mg = jnp.split(proj, IN_OFFSETS, axis=-1)
        y_h = hgrn2_branch(hq, hf, hi, hz, lb_all[l], hgrn_norm_w[l])
        y_g = gla_branch(gq, gk, gv, gz, ga, gla_alpha_w[l], gla_alpha_b[l], gla_norm_w[l])
        u_h = y_h @ w_branch[l, 0]
        u_g = y_g @ w_branch[l, 1]
        mg = jax.nn.sigmoid(mg.reshape(B, T, N_BRANCH, D_MODEL))
        merged = mg[:, :, 0] * u_h + mg[:, :, 1] * u_g
        x = x + gate[:, None, :] * (merged @ w_out[l])
    return rms_norm(x, final_norm_w)
```

```cpp
#include <hip/hip_runtime.h>
#include <hip/hip_cooperative_groups.h>
#include <cstdio>
#include <cstdint>
namespace cg = cooperative_groups;

#define LAS __attribute__((address_space(3)))
typedef unsigned short bf16_t;
typedef short bf16x8 __attribute__((ext_vector_type(8)));
typedef float f32x4 __attribute__((ext_vector_type(4)));
typedef float f32x2 __attribute__((ext_vector_type(2)));
typedef unsigned u32x4 __attribute__((ext_vector_type(4)));
typedef unsigned u32x2 __attribute__((ext_vector_type(2)));

constexpr int MROWS = 16384, DM = 1024, SEQ = 8192, LDP = 5632, DIN = 9232;
constexpr float EPS = 1e-6f;
constexpr size_t WS_MOD = 4096, WS_LB = 53248, WS_SS = 65536, WS_DSC = 589824, WS_W = 1048576, W_LAYER = 26214400;
constexpr size_t WS_D1 = WS_W + 2 * W_LAYER, WS_P = WS_D1 + (size_t)MROWS * DM * 2, WS_END = WS_P + (size_t)MROWS * LDP * 2;
constexpr size_t OUT_H = 0, OUT_ST = 33554432;
constexpr int LDS_BYTES = 147456;

__device__ __forceinline__ unsigned cvt_pk_bf16(float lo, float hi) { unsigned r; asm volatile("v_cvt_pk_bf16_f32 %0, %1, %2" : "=v"(r) : "v"(lo), "v"(hi)); return r; }
__device__ __forceinline__ float bf_lo(unsigned w) { return __uint_as_float(w << 16); }
__device__ __forceinline__ float bf_hi(unsigned w) { return __uint_as_float(w & 0xffff0000u); }
__device__ __forceinline__ float fsigmoid(float v) { return __builtin_amdgcn_rcpf(1.f + __expf(-v)); }
__device__ __forceinline__ int opaque_tid() { int t = threadIdx.x; asm volatile("" : "+v"(t)); return t; }
__device__ __forceinline__ float wave_sum(float v) {
#pragma unroll
    for (int o = 1; o < 64; o <<= 1) v += __shfl_xor(v, o);
    return v;
}

namespace pg8 {
constexpr int BM = 256, BK = 64, HALF = 128, HTB = HALF * BK * 2, STAGE_BYTES = 8 * HTB, NXCD = 8, WGM = 8;
__host__ __device__ __forceinline__ int lds_byte(int r, int c) { const int st = (r >> 4) * 2 + (c >> 5), rr = r & 15, cc = c & 31, ob = rr * 64 + cc * 2; return st * 1024 + (ob ^ (((ob >> 9) & 1) << 5)); }
__host__ __device__ __forceinline__ void stage_rc(int b, int& R, int& C) { const int st = b / 1024, sb = b % 1024, swz = sb ^ (((sb >> 9) & 1) << 5); R = (st >> 1) * 16 + swz / 64; C = (st & 1) * 32 + (swz % 64) / 2; }
__host__ __device__ __forceinline__ int perm32(int rho) { const int n = rho >> 4, i = rho & 15; return 8 * (i >> 2) + 4 * n + (i & 3); }

struct Unit { int pm, pn, br; unsigned ao, bo; };
struct Gemm { const bf16_t* A; const bf16_t* Bt; int lda, K; };

struct StaticOrder {
    int nM, nN, nwg, G, c;
    __host__ __device__ void init(int M, int N, int G_, int c_) { nM = M / BM; nN = N / BM; nwg = nM * nN; G = G_; c = c_; }
    __host__ __device__ bool next(int i, Unit& u) const {
        const long L = (long)i * G + c; if (L >= nwg) return false;
        int wgid = (int)L; { const int q = nwg / NXCD, r = nwg % NXCD, xcd = wgid % NXCD, off = wgid / NXCD; wgid = (xcd < r ? xcd * (q + 1) : r * (q + 1) + (xcd - r) * q) + off; }
        const int nig = WGM * nN, gid = wgid / nig, fm = gid * WGM, gsz = (nM - fm) < WGM ? (nM - fm) : WGM;
        u.pm = fm + ((wgid % nig) % gsz); u.pn = (wgid % nig) / gsz; u.br = 0; u.ao = 0u; u.bo = 0u; return true;
    }
};
struct BranchOrder {
    StaticOrder s;
    __host__ __device__ bool next(int i, Unit& u) const { if (!s.next(i >> 1, u)) return false; u.br = i & 1; u.ao = (i & 1) ? 4096u * 2u : 0u; u.bo = (i & 1) ? 1024u * 1024u * 2u : 0u; return true; }
};

template <class Epi, class Sched>
__device__ __forceinline__ void gemm_phase(LAS unsigned char* lds, const Gemm g, const Sched& S, const Epi& E) {
    const int tid = opaque_tid(), wid = __builtin_amdgcn_readfirstlane(tid >> 6), lane = tid & 63, wr = wid >> 2, wc = wid & 3, fr = lane & 15, fq = lane >> 4;
    const int K = g.K, nt = K / BK, lda = g.lda;
    unsigned voffA[2], voffB[2];
#pragma unroll
    for (int i = 0; i < 2; ++i) { int R, C; stage_rc(tid * 16 + i * 8192, R, C); const int Rb = Epi::PERM ? ((R & ~31) + perm32(R & 31)) : R;
        voffA[i] = (unsigned)(R * lda + C) * 2u; voffB[i] = (unsigned)(Rb * K + C) * 2u;
        asm volatile("" : "+v"(voffA[i]), "+v"(voffB[i])); }
    const size_t kstep = (size_t)(BK * 2);
    const size_t hA = (size_t)HALF * lda * 2, tA = 2 * hA, hB = (size_t)HALF * K * 2, tB = 2 * hB;
    const unsigned ldsw = (unsigned)wid * 1024u;
    const int aoff = lds_byte(wr * 64 + fr, fq * 8), boff = lds_byte(wc * 32 + fr, fq * 8);
#define PG8_SA(b, h) (((b) * 2 + (h)) * HTB)
#define PG8_SB(b, h) ((4 + (b) * 2 + (h)) * HTB)
#define PG8_STAGE(bufoff, gbase, voff) do { _Pragma("unroll") for (int _i = 0; _i < 2; ++_i) \
        __builtin_amdgcn_global_load_lds((const unsigned*)((const char*)(gbase) + (voff)[_i]), (LAS unsigned*)(lds + (bufoff) + ldsw + _i * 8192), 16, 0, 0); } while (0)
#define PG8_LDA(dst, b, h) do { _Pragma("unroll") for (int m = 0; m < 4; ++m) _Pragma("unroll") for (int k = 0; k < 2; ++k) dst[m][k] = *(const LAS bf16x8*)(lds + PG8_SA(b, h) + aoff + m * 2048 + k * 1024); } while (0)
#define PG8_LDB(dst, b, h) do { _Pragma("unroll") for (int n = 0; n < 2; ++n) _Pragma("unroll") for (int k = 0; k < 2; ++k) dst[n][k] = *(const LAS bf16x8*)(lds + PG8_SB(b, h) + boff + n * 2048 + k * 1024); } while (0)
#define PG8_MMA(ai, bj, At, Bt) do { __builtin_amdgcn_s_setprio(1); _Pragma("unroll") for (int m = 0; m < 4; ++m) _Pragma("unroll") for (int n = 0; n < 2; ++n) _Pragma("unroll") for (int k = 0; k < 2; ++k) \
        acc[ai][bj][m][n] = __builtin_amdgcn_mfma_f32_16x16x32_bf16(Bt[n][k], At[m][k], acc[ai][bj][m][n], 0, 0, 0); __builtin_amdgcn_s_setprio(0); } while (0)
#define PG8_WAIT_V(n) asm volatile("s_waitcnt vmcnt(" #n ")" ::: "memory")
#define PG8_WAIT_L(n) asm volatile("s_waitcnt lgkmcnt(" #n ")" ::: "memory")
#define PG8_BAR __builtin_amdgcn_s_barrier()
#define PG8_SCHED __builtin_amdgcn_sched_barrier(0)
    Unit cur, nxt; int ui = 0;
    if (!S.next(0, cur)) return;
    f32x4 acc[2][2][4][2];
#pragma unroll
    for (int a = 0; a < 2; ++a)
#pragma unroll
        for (int b = 0; b < 2; ++b)
#pragma unroll
            for (int m = 0; m < 4; ++m)
#pragma unroll
                for (int n = 0; n < 2; ++n) acc[a][b][m][n] = (f32x4){0.f, 0.f, 0.f, 0.f};
    bf16x8 At[4][2], B0[2][2], B1[2][2];
    const char* cA = (const char*)g.A + (size_t)cur.pm * tA + cur.ao; const char* cB = (const char*)g.Bt + (size_t)cur.pn * tB + cur.bo;
    PG8_STAGE(PG8_SB(0, 0), cB, voffB); PG8_STAGE(PG8_SB(0, 1), cB + hB, voffB); PG8_STAGE(PG8_SA(0, 0), cA, voffA); PG8_STAGE(PG8_SA(0, 1), cA + hA, voffA);
    if (wr == 1) PG8_BAR;
    PG8_WAIT_V(2); PG8_BAR;
    PG8_STAGE(PG8_SB(1, 0), cB + kstep, voffB); PG8_STAGE(PG8_SA(1, 0), cA + kstep, voffA); PG8_STAGE(PG8_SB(1, 1), cB + hB + kstep, voffB);
    PG8_WAIT_V(6); PG8_BAR;
    for (;;) {
        const bool has_next = S.next(ui + 1, nxt);
        const char* nA = has_next ? (const char*)g.A + (size_t)nxt.pm * tA + nxt.ao : cA; const char* nB = has_next ? (const char*)g.Bt + (size_t)nxt.pn * tB + nxt.bo : cB;
        for (int t = 0; t < nt; t += 2) {
            const bool last = (t == nt - 2);
            const char* a1 = cA + (size_t)(t + 1) * kstep;
            const char* a2 = last ? nA : cA + (size_t)(t + 2) * kstep; const char* b2 = last ? nB : cB + (size_t)(t + 2) * kstep;
            const char* a3 = a2 + kstep; const char* b3 = b2 + kstep;
            PG8_LDB(B0, 0, 0); PG8_LDB(B1, 0, 1); PG8_SCHED; PG8_LDA(At, 0, 0); PG8_STAGE(PG8_SA(1, 1), a1 + hA, voffA);
            PG8_WAIT_V(8); PG8_WAIT_L(0); PG8_BAR; PG8_MMA(0, 0, At, B0); PG8_MMA(0, 1, At, B1); PG8_BAR; PG8_SCHED;
            PG8_LDA(At, 0, 1); PG8_STAGE(PG8_SB(0, 0), b2, voffB); PG8_STAGE(PG8_SB(0, 1), b2 + hB, voffB); PG8_STAGE(PG8_SA(0, 0), a2, voffA);
            PG8_WAIT_V(8); PG8_WAIT_L(0); PG8_BAR; PG8_MMA(1, 0, At, B0); PG8_MMA(1, 1, At, B1); PG8_BAR; PG8_SCHED;
            PG8_LDB(B0, 1, 0); PG8_LDB(B1, 1, 1); PG8_SCHED; PG8_LDA(At, 1, 0); PG8_STAGE(PG8_SA(0, 1), a2 + hA, voffA);
            PG8_WAIT_V(8); PG8_WAIT_L(0); PG8_BAR; PG8_MMA(0, 0, At, B0); PG8_MMA(0, 1, At, B1); PG8_BAR; PG8_SCHED;
            PG8_LDA(At, 1, 1); PG8_STAGE(PG8_SB(1, 0), b3, voffB); PG8_STAGE(PG8_SB(1, 1), b3 + hB, voffB); PG8_STAGE(PG8_SA(1, 0), a3, voffA);
            PG8_WAIT_V(8); PG8_WAIT_L(0); PG8_BAR; PG8_MMA(1, 0, At, B0); PG8_MMA(1, 1, At, B1); PG8_BAR; PG8_SCHED;
        }
        if (wr == 0) PG8_BAR;
        E(acc, cur, wr, wc, fr, fq);
        if (!has_next) break;
#pragma unroll
        for (int a = 0; a < 2; ++a)
#pragma unroll
            for (int b = 0; b < 2; ++b)
#pragma unroll
                for (int m = 0; m < 4; ++m)
#pragma unroll
                    for (int n = 0; n < 2; ++n) acc[a][b][m][n] = (f32x4){0.f, 0.f, 0.f, 0.f};
        cur = nxt; cA = nA; cB = nB; ++ui;
        if (wr == 1) PG8_BAR;
    }
    PG8_WAIT_V(0);
    PG8_BAR;
#undef PG8_SA
#undef PG8_SB
#undef PG8_STAGE
#undef PG8_LDA
#undef PG8_LDB
#undef PG8_MMA
#undef PG8_WAIT_V
#undef PG8_WAIT_L
#undef PG8_BAR
#undef PG8_SCHED
}
}
using pg8::Unit;

__device__ __forceinline__ void unpack8(const u32x4 w, float (&o)[8]) { o[0] = bf_lo(w.x); o[1] = bf_hi(w.x); o[2] = bf_lo(w.y); o[3] = bf_hi(w.y); o[4] = bf_lo(w.z); o[5] = bf_hi(w.z); o[6] = bf_lo(w.w); o[7] = bf_hi(w.w); }
__device__ __forceinline__ u32x4 pack8(const float (&v)[8]) { u32x4 w; w.x = cvt_pk_bf16(v[0], v[1]); w.y = cvt_pk_bf16(v[2], v[3]); w.z = cvt_pk_bf16(v[4], v[5]); w.w = cvt_pk_bf16(v[6], v[7]); return w; }

struct EpiA1 {
    static constexpr bool PERM = true;
    bf16_t* P; const float* lb; const float* ab;
    __device__ __forceinline__ void operator()(const f32x4 (&acc)[2][2][4][2], const Unit& u, int wr, int wc, int fr, int fq) const {
        const int pn = u.pn;
        const int type = pn < 4 ? 0 : pn < 8 ? 1 : pn < 12 ? 2 : pn < 14 ? 3 : pn < 20 ? 2 : 4;
        const int row0 = u.pm * 256 + wr * 64 + fr, colb = pn * 256 + wc * 32 + 8 * fq;
#pragma unroll
        for (int bj = 0; bj < 2; ++bj) {
            const int col = colb + bj * 128;
            float pr[8];
#pragma unroll
            for (int e = 0; e < 8; ++e) pr[e] = 0.f;
            if (type == 1) { const f32x4 p0 = *(const f32x4*)(lb + col - 1024), p1 = *(const f32x4*)(lb + col - 1024 + 4); pr[0] = p0[0]; pr[1] = p0[1]; pr[2] = p0[2]; pr[3] = p0[3]; pr[4] = p1[0]; pr[5] = p1[1]; pr[6] = p1[2]; pr[7] = p1[3]; }
            if (type == 4) { const f32x4 p0 = *(const f32x4*)(ab + col - 5120), p1 = *(const f32x4*)(ab + col - 5120 + 4); pr[0] = p0[0]; pr[1] = p0[1]; pr[2] = p0[2]; pr[3] = p0[3]; pr[4] = p1[0]; pr[5] = p1[1]; pr[6] = p1[2]; pr[7] = p1[3]; }
#pragma unroll
            for (int ai = 0; ai < 2; ++ai)
#pragma unroll
                for (int m = 0; m < 4; ++m) {
                    const int row = row0 + ai * 128 + m * 16;
                    float v[8];
#pragma unroll
                    for (int e = 0; e < 4; ++e) { v[e] = acc[ai][bj][m][0][e]; v[4 + e] = acc[ai][bj][m][1][e]; }
                    if (type == 0) {
#pragma unroll
                        for (int e = 0; e < 8; ++e) v[e] = v[e] * fsigmoid(v[e]);
                    } else if (type == 1) {
#pragma unroll
                        for (int e = 0; e < 8; ++e) { const float f = pr[e] + (1.f - pr[e]) * fsigmoid(v[e]); v[e] = __logf(fmaxf(f, 1e-20f)); }
                    } else if (type == 3) {
#pragma unroll
                        for (int e = 0; e < 8; ++e) v[e] *= 0.08838834764831845f;
                    } else if (type == 4) {
#pragma unroll
                        for (int e = 0; e < 8; ++e) { const float z = v[e] + pr[e]; v[e] = (fminf(z, 0.f) - __logf(1.f + __expf(-fabsf(z)))) * 0.0625f; }
                    }
                    *(u32x4*)(P + (size_t)row * LDP + col) = pack8(v);
                }
        }
    }
};
struct EpiA2 {
    static constexpr bool PERM = true;
    bf16_t* P; const float* SS; const float* hnw; const float* gnw;
    __device__ __forceinline__ void operator()(const f32x4 (&acc)[2][2][4][2], const Unit& u, int wr, int wc, int fr, int fq) const {
        const int pn = u.pn;
        const int row0 = u.pm * 256 + wr * 64 + fr, cw = wc * 32 + 8 * fq;
#pragma unroll
        for (int bj = 0; bj < 2; ++bj) {
            const int cin = cw + bj * 128;
            float nw[8];
#pragma unroll
            for (int e = 0; e < 8; ++e) nw[e] = 1.f;
            int dcol;
            if (pn < 4) { dcol = pn * 256 + cin; const f32x4 p0 = *(const f32x4*)(hnw + dcol), p1 = *(const f32x4*)(hnw + dcol + 4); nw[0] = p0[0]; nw[1] = p0[1]; nw[2] = p0[2]; nw[3] = p0[3]; nw[4] = p1[0]; nw[5] = p1[1]; nw[6] = p1[2]; nw[7] = p1[3]; }
            else if (pn < 8) { dcol = 4096 + (pn - 4) * 256 + cin; const f32x4 p0 = *(const f32x4*)(gnw + cin), p1 = *(const f32x4*)(gnw + cin + 4); nw[0] = p0[0]; nw[1] = p0[1]; nw[2] = p0[2]; nw[3] = p0[3]; nw[4] = p1[0]; nw[5] = p1[1]; nw[6] = p1[2]; nw[7] = p1[3]; }
            else dcol = 1024 + (pn - 8) * 256 + cin;
#pragma unroll
            for (int ai = 0; ai < 2; ++ai)
#pragma unroll
                for (int m = 0; m < 4; ++m) {
                    const int row = row0 + ai * 128 + m * 16;
                    float v[8];
#pragma unroll
                    for (int e = 0; e < 4; ++e) { v[e] = acc[ai][bj][m][0][e]; v[4 + e] = acc[ai][bj][m][1][e]; }
                    bf16_t* dst = P + (size_t)row * LDP + dcol;
                    if (pn < 8) {
                        const float ssv = (pn < 4) ? SS[row * 8] : SS[row * 8 + 1 + (pn - 4)];
                        const float rstd = rsqrtf(ssv * ((pn < 4) ? (1.f / 1024.f) : (1.f / 256.f)) + EPS);
                        float o[8]; unpack8(*(const u32x4*)dst, o);
#pragma unroll
                        for (int e = 0; e < 8; ++e) v[e] = o[e] * rstd * nw[e] * (v[e] * fsigmoid(v[e]));
                    } else {
#pragma unroll
                        for (int e = 0; e < 8; ++e) v[e] = fsigmoid(v[e]);
                    }
                    *(u32x4*)dst = pack8(v);
                }
        }
    }
};
struct EpiC1 {
    static constexpr bool PERM = true;
    bf16_t* P;
    __device__ __forceinline__ void operator()(const f32x4 (&acc)[2][2][4][2], const Unit& u, int wr, int wc, int fr, int fq) const {
        const int br = u.br;
        const int row0 = u.pm * 256 + wr * 64 + fr, colb = u.pn * 256 + wc * 32 + 8 * fq;
#pragma unroll
        for (int bj = 0; bj < 2; ++bj) {
            const int c = colb + bj * 128;
#pragma unroll
            for (int ai = 0; ai < 2; ++ai)
#pragma unroll
                for (int m = 0; m < 4; ++m) {
                    const int row = row0 + ai * 128 + m * 16;
                    float v[8], gt[8];
#pragma unroll
                    for (int e = 0; e < 4; ++e) { v[e] = acc[ai][bj][m][0][e]; v[4 + e] = acc[ai][bj][m][1][e]; }
                    bf16_t* rp = P + (size_t)row * LDP;
                    unpack8(*(const u32x4*)(rp + 1024 + 1024 * br + c), gt);
#pragma unroll
                    for (int e = 0; e < 8; ++e) v[e] *= gt[e];
                    if (br) { float o[8]; unpack8(*(const u32x4*)(rp + 3072 + c), o);
#pragma unroll
                        for (int e = 0; e < 8; ++e) v[e] += o[e]; }
                    *(u32x4*)(rp + 3072 + c) = pack8(v);
                }
        }
    }
};
struct EpiC2a {
    static constexpr bool PERM = true;
    bf16_t* D1; const float* mod;
    __device__ __forceinline__ void operator()(const f32x4 (&acc)[2][2][4][2], const Unit& u, int wr, int wc, int fr, int fq) const {
        const int row0 = u.pm * 256 + wr * 64 + fr, colb = u.pn * 256 + wc * 32 + 8 * fq;
        const float* gp = mod + (u.pm >> 5) * 3072 + 2048;
#pragma unroll
        for (int bj = 0; bj < 2; ++bj) {
            const int c = colb + bj * 128;
            const f32x4 g0 = *(const f32x4*)(gp + c), g1 = *(const f32x4*)(gp + c + 4);
#pragma unroll
            for (int ai = 0; ai < 2; ++ai)
#pragma unroll
                for (int m = 0; m < 4; ++m) {
                    const int row = row0 + ai * 128 + m * 16;
                    float v[8];
#pragma unroll
                    for (int e = 0; e < 4; ++e) { v[e] = acc[ai][bj][m][0][e] * g0[e]; v[4 + e] = acc[ai][bj][m][1][e] * g1[e]; }
                    *(u32x4*)(D1 + (size_t)row * DM + c) = pack8(v);
                }
        }
    }
};
struct EpiC2b {
    static constexpr bool PERM = false;
    const float* x; const bf16_t* D1; float* out; const float* mod;
    __device__ __forceinline__ void operator()(const f32x4 (&acc)[2][2][4][2], const Unit& u, int wr, int wc, int fr, int fq) const {
        const int row0 = u.pm * 256 + wr * 64 + fr, colb = u.pn * 256 + wc * 32 + 4 * fq;
        const float* gp = mod + (u.pm >> 5) * 3072 + 2048;
#pragma unroll
        for (int bj = 0; bj < 2; ++bj)
#pragma unroll
            for (int n = 0; n < 2; ++n) {
                const int c = colb + bj * 128 + n * 16;
                const f32x4 gv = *(const f32x4*)(gp + c);
#pragma unroll
                for (int ai = 0; ai < 2; ++ai)
#pragma unroll
                    for (int m = 0; m < 4; ++m) {
                        const size_t off = (size_t)(row0 + ai * 128 + m * 16) * DM + c;
                        const f32x4 xv = *(const f32x4*)(x + off); const u32x2 d = *(const u32x2*)(D1 + off);
                        f32x4 o = xv + acc[ai][bj][m][n] * gv; o[0] += bf_lo(d.x); o[1] += bf_hi(d.x); o[2] += bf_lo(d.y); o[3] += bf_hi(d.y);
                        *(f32x4*)(out + off) = o;
                    }
            }
    }
};

__device__ __forceinline__ unsigned f2bf(float f) { unsigned u = __float_as_uint(f); return (u + 0x7fffu + ((u >> 16) & 1u)) >> 16; }
__device__ __forceinline__ unsigned pk2(float lo, float hi) { return f2bf(lo) | (f2bf(hi) << 16); }
__device__ __forceinline__ void tr_write(bf16_t* WT, int row_off, int n0, int k0, LAS float* scr, int lane) {
    asm volatile("s_waitcnt lgkmcnt(0)" ::: "memory");
    const int c = lane & 7;
#pragma unroll
    for (int j = 0; j < 4; ++j) { const int n = (lane >> 3) + 8 * j; const LAS float* s = scr + (8 * c) * 33 + n;
        u32x4 o; o.x = pk2(s[0 * 33], s[1 * 33]); o.y = pk2(s[2 * 33], s[3 * 33]); o.z = pk2(s[4 * 33], s[5 * 33]); o.w = pk2(s[6 * 33], s[7 * 33]);
        *(u32x4*)(WT + (size_t)(row_off + n0 + n) * 1024 + k0 + 8 * c) = o; }
    asm volatile("s_waitcnt lgkmcnt(0)" ::: "memory");
}
__device__ __forceinline__ void tr_item(const float* W, int ldw, int col0, bf16_t* WT, int row_off, LAS float* scr, int item, int nblk, int lane) {
    const int kb = item / nblk, nb = item % nblk, k0 = 64 * kb, n0 = 32 * nb;
#pragma unroll 8
    for (int i = 0; i < 32; ++i) { const int kk = 2 * i + (lane >> 5); scr[kk * 33 + (lane & 31)] = W[(size_t)(k0 + kk) * ldw + col0 + n0 + (lane & 31)]; }
    tr_write(WT, row_off, n0, k0, scr, lane);
}
__device__ __forceinline__ void tr_item_la(const float* win, const float* aw, bf16_t* WT, int row_off, LAS float* scr, int item, int lane) {
    const int kb = item / 16, nb = item % 16, k0 = 64 * kb, n0 = 32 * nb;
    float awr[16];
#pragma unroll
    for (int r = 0; r < 16; ++r) awr[r] = aw[r * 512 + n0 + (lane & 31)];
#pragma unroll 4
    for (int i = 0; i < 32; ++i) { const int kk = 2 * i + (lane >> 5); const float* wr_ = win + (size_t)(k0 + kk) * DIN + 7168; float s = 0.f;
#pragma unroll
        for (int r = 0; r < 16; ++r) s += wr_[r] * awr[r];
        scr[kk * 33 + (lane & 31)] = s; }
    tr_write(WT, row_off, n0, k0, scr, lane);
}

constexpr int L_RAWQ = 0, L_RAWK = 16384, L_RAWG = 32768, L_RAWV = 49152;
constexpr int L_ST = 0, L_PB = 36864;
constexpr int L_QM = 65536, L_KM = 82944, L_KET = 100352, L_VT = 118784;
constexpr int L_PSUM = 137216, L_EBREF = 141312, L_EBLAST = 141824, L_RED = 142336;
static_assert(L_RED + 2048 <= LDS_BYTES, "LDS map");

template <bool OUT>
__device__ __forceinline__ void la_item(LAS unsigned char* lds, bf16_t* P, float* ST, float* DSC, float* SS, int item) {
    const int tid = opaque_tid();
    const int lane = tid & 63, w = __builtin_amdgcn_readfirstlane(tid >> 6), fr = lane & 15, fq = lane >> 4;
    const int sc = item & 15, vh = (item >> 4) & 15, b = item >> 8;
    const int row0 = b * SEQ + sc * 512;
    int qcol, kcol, gcol, vcol, sscol;
    if (vh < 8) { qcol = 128 * vh; kcol = -1; gcol = 1024 + 128 * vh; vcol = 2048 + 128 * vh; sscol = 0; }
    else { const int j = (vh - 8) >> 1, e = (vh - 8) & 1; qcol = 3072 + 128 * j; kcol = 3584 + 128 * j; gcol = 5120 + 128 * j; vcol = 4096 + 256 * j + 128 * e; sscol = 1 + j; }
    const int ocol = (vh < 8) ? qcol : vcol;
    float* stp = ST + (size_t)item * 16384;
    f32x4 S[8];
#pragma unroll
    for (int j = 0; j < 8; ++j)
#pragma unroll
        for (int i = 0; i < 4; ++i) S[j][i] = OUT ? stp[(16 * w + 4 * fq + i) * 128 + 16 * j + fr] : 0.f;
    float btot0 = 0.f, btot1 = 0.f;
#pragma unroll 1
    for (int c = 0; c < 8; ++c) {
        const bf16_t* rb = P + (size_t)(row0 + 64 * c) * LDP;
#pragma unroll
        for (int i = 0; i < 2; ++i) {
            const int p = tid + 512 * i, r = p >> 4, c8 = p & 15;
            const bf16_t* src = rb + (size_t)r * LDP + 8 * c8;
            const int lo = r * 256 + c8 * 16;
            *(LAS u32x4*)(lds + L_RAWG + lo) = *(const u32x4*)(src + gcol);
            *(LAS u32x4*)(lds + L_RAWV + lo) = *(const u32x4*)(src + vcol);
            if (kcol >= 0) *(LAS u32x4*)(lds + L_RAWK + lo) = *(const u32x4*)(src + kcol);
            if (OUT) *(LAS u32x4*)(lds + L_RAWQ + lo) = *(const u32x4*)(src + qcol);
        }
        __syncthreads();
        {
            float s0 = 0.f, s1 = 0.f;
#pragma unroll
            for (int j = 0; j < 8; ++j) { const unsigned gw = *(const LAS unsigned*)(lds + L_RAWG + (8 * w + j) * 256 + lane * 4); s0 += bf_lo(gw); s1 += bf_hi(gw); }
            *(LAS f32x2*)(lds + L_PSUM + (w * 128 + 2 * lane) * 4) = (f32x2){s0, s1};
        }
        __syncthreads();
        {
            float off0 = 0.f, off1 = 0.f, bref0 = 0.f, bref1 = 0.f, bl0 = 0.f, bl1 = 0.f;
#pragma unroll
            for (int ww = 0; ww < 8; ++ww) { const f32x2 p = *(const LAS f32x2*)(lds + L_PSUM + (ww * 128 + 2 * lane) * 4);
                if (ww < w) { off0 += p.x; off1 += p.y; } if (ww < 4) { bref0 += p.x; bref1 += p.y; } bl0 += p.x; bl1 += p.y; }
            float run0 = off0, run1 = off1;
            float ke0[8], ke1[8]; unsigned vv[8];
#pragma unroll
            for (int j = 0; j < 8; ++j) {
                const int t = 8 * w + j;
                const unsigned gw = *(const LAS unsigned*)(lds + L_RAWG + t * 256 + lane * 4);
                const float ga = bf_lo(gw), gb = bf_hi(gw);
                run0 += ga; run1 += gb;
                float kk0, kk1;
                if (kcol < 0) { kk0 = 1.f - __expf(ga); kk1 = 1.f - __expf(gb); }
                else { const unsigned kw = *(const LAS unsigned*)(lds + L_RAWK + t * 256 + lane * 4); kk0 = bf_lo(kw); kk1 = bf_hi(kw); }
                ke0[j] = kk0 * __expf(bl0 - run0); ke1[j] = kk1 * __expf(bl1 - run1);
                if (OUT) {
                    const unsigned qw = *(const LAS unsigned*)(lds + L_RAWQ + t * 256 + lane * 4);
                    *(LAS unsigned*)(lds + L_QM + t * 272 + lane * 4) = cvt_pk_bf16(bf_lo(qw) * __expf(run0 - bref0), bf_hi(qw) * __expf(run1 - bref1));
                    *(LAS unsigned*)(lds + L_KM + t * 272 + lane * 4) = cvt_pk_bf16(kk0 * __expf(bref0 - run0), kk1 * __expf(bref1 - run1));
                }
                vv[j] = *(const LAS unsigned*)(lds + L_RAWV + t * 256 + lane * 4);
            }
            u32x4 k0w, k1w, v0w, v1w;
            k0w.x = cvt_pk_bf16(ke0[0], ke0[1]); k0w.y = cvt_pk_bf16(ke0[2], ke0[3]); k0w.z = cvt_pk_bf16(ke0[4], ke0[5]); k0w.w = cvt_pk_bf16(ke0[6], ke0[7]);
            k1w.x = cvt_pk_bf16(ke1[0], ke1[1]); k1w.y = cvt_pk_bf16(ke1[2], ke1[3]); k1w.z = cvt_pk_bf16(ke1[4], ke1[5]); k1w.w = cvt_pk_bf16(ke1[6], ke1[7]);
            v0w.x = (vv[0] & 0xffffu) | (vv[1] << 16); v0w.y = (vv[2] & 0xffffu) | (vv[3] << 16); v0w.z = (vv[4] & 0xffffu) | (vv[5] << 16); v0w.w = (vv[6] & 0xffffu) | (vv[7] << 16);
            v1w.x = (vv[0] >> 16) | (vv[1] & 0xffff0000u); v1w.y = (vv[2] >> 16) | (vv[3] & 0xffff0000u); v1w.z = (vv[4] >> 16) | (vv[5] & 0xffff0000u); v1w.w = (vv[6] >> 16) | (vv[7] & 0xffff0000u);
            *(LAS u32x4*)(lds + L_KET + (2 * lane) * 144 + w * 16) = k0w; *(LAS u32x4*)(lds + L_KET + (2 * lane + 1) * 144 + w * 16) = k1w;
            *(LAS u32x4*)(lds + L_VT + (2 * lane) * 144 + w * 16) = v0w; *(LAS u32x4*)(lds + L_VT + (2 * lane + 1) * 144 + w * 16) = v1w;
            if (w == 0) { *(LAS f32x2*)(lds + L_EBREF + lane * 8) = (f32x2){__expf(bref0), __expf(bref1)}; *(LAS f32x2*)(lds + L_EBLAST + lane * 8) = (f32x2){__expf(bl0), __expf(bl1)}; }
            btot0 += bl0; btot1 += bl1;
        }
        __syncthreads();
        if (OUT) {
            {
                const f32x4 er = *(const LAS f32x4*)(lds + L_EBREF + (16 * w + 4 * fq) * 4);
#pragma unroll
                for (int j = 0; j < 8; ++j) { u32x2 o; o.x = cvt_pk_bf16(S[j][0] * er[0], S[j][1] * er[1]); o.y = cvt_pk_bf16(S[j][2] * er[2], S[j][3] * er[3]);
                    *(LAS u32x2*)(lds + L_ST + (16 * j + fr) * 272 + (16 * w + 4 * fq) * 2) = o; }
#pragma unroll
                for (int q = 0; q < 2; ++q) {
                    const int id = 2 * w + q, st = id >> 2, tt = id & 3;
                    f32x4 a = (f32x4){0.f, 0.f, 0.f, 0.f};
                    if (tt >= st) {
#pragma unroll
                        for (int kk = 0; kk < 4; ++kk) {
                            const bf16x8 xk = *(const LAS bf16x8*)(lds + L_KM + (16 * st + fr) * 272 + (32 * kk + 8 * fq) * 2);
                            const bf16x8 yq = *(const LAS bf16x8*)(lds + L_QM + (16 * tt + fr) * 272 + (32 * kk + 8 * fq) * 2);
                            a = __builtin_amdgcn_mfma_f32_16x16x32_bf16(xk, yq, a, 0, 0, 0);
                        }
                    }
                    const int t = 16 * tt + fr, s0 = 16 * st + 4 * fq;
                    u32x2 o; o.x = cvt_pk_bf16(s0 <= t ? a[0] : 0.f, s0 + 1 <= t ? a[1] : 0.f); o.y = cvt_pk_bf16(s0 + 2 <= t ? a[2] : 0.f, s0 + 3 <= t ? a[3] : 0.f);
                    *(LAS u32x2*)(lds + L_PB + t * 144 + s0 * 2) = o;
                }
            }
            __syncthreads();
#pragma unroll
            for (int tt = 0; tt < 4; ++tt) {
                f32x4 a = (f32x4){0.f, 0.f, 0.f, 0.f};
#pragma unroll
                for (int kk = 0; kk < 4; ++kk) {
                    const bf16x8 xs = *(const LAS bf16x8*)(lds + L_ST + (16 * w + fr) * 272 + (32 * kk + 8 * fq) * 2);
                    const bf16x8 yq = *(const LAS bf16x8*)(lds + L_QM + (16 * tt + fr) * 272 + (32 * kk + 8 * fq) * 2);
                    a = __builtin_amdgcn_mfma_f32_16x16x32_bf16(xs, yq, a, 0, 0, 0);
                }
#pragma unroll
                for (int ss = 0; ss < 2; ++ss) {
                    const bf16x8 xv = *(const LAS bf16x8*)(lds + L_VT + (16 * w + fr) * 144 + (32 * ss + 8 * fq) * 2);
                    const bf16x8 yp = *(const LAS bf16x8*)(lds + L_PB + (16 * tt + fr) * 144 + (32 * ss + 8 * fq) * 2);
                    a = __builtin_amdgcn_mfma_f32_16x16x32_bf16(xv, yp, a, 0, 0, 0);
                }
                float q2 = a[0] * a[0] + a[1] * a[1] + a[2] * a[2] + a[3] * a[3];
                q2 += __shfl_xor(q2, 16); q2 += __shfl_xor(q2, 32);
                if (fq == 0) *(LAS float*)(lds + L_RED + (w * 64 + 16 * tt + fr) * 4) = q2;
                u32x2 o; o.x = cvt_pk_bf16(a[0], a[1]); o.y = cvt_pk_bf16(a[2], a[3]);
                *(u32x2*)(P + (size_t)(row0 + 64 * c + 16 * tt + fr) * LDP + ocol + 16 * w + 4 * fq) = o;
            }
        }
        {
            const f32x4 el = *(const LAS f32x4*)(lds + L_EBLAST + (16 * w + 4 * fq) * 4);
            bf16x8 xk[2];
#pragma unroll
            for (int ss = 0; ss < 2; ++ss) xk[ss] = *(const LAS bf16x8*)(lds + L_KET + (16 * w + fr) * 144 + (32 * ss + 8 * fq) * 2);
#pragma unroll
            for (int j = 0; j < 8; ++j) {
                S[j] = S[j] * el;
#pragma unroll
                for (int ss = 0; ss < 2; ++ss) {
                    const bf16x8 yv = *(const LAS bf16x8*)(lds + L_VT + (16 * j + fr) * 144 + (32 * ss + 8 * fq) * 2);
                    S[j] = __builtin_amdgcn_mfma_f32_16x16x32_bf16(xk[ss], yv, S[j], 0, 0, 0);
                }
            }
        }
        __syncthreads();
        if (OUT) {
            if (tid < 64) { float tot = 0.f;
#pragma unroll
                for (int ww = 0; ww < 8; ++ww) tot += *(const LAS float*)(lds + L_RED + (ww * 64 + tid) * 4);
                atomicAdd(SS + (size_t)(row0 + 64 * c + tid) * 8 + sscol, tot); }
        }
    }
    if (!OUT) {
#pragma unroll
        for (int j = 0; j < 8; ++j)
#pragma unroll
            for (int i = 0; i < 4; ++i) stp[(16 * w + 4 * fq + i) * 128 + 16 * j + fr] = S[j][i];
        if (w == 0) *(f32x2*)(DSC + (size_t)item * 128 + 2 * lane) = (f32x2){__expf(btot0), __expf(btot1)};
    }
}

struct Args { const float* x; const float* c; const float* ada_w; const float* ada_b; const float* norm_w; const float* w_in; const float* lb_logits; const float* hnw;
              const float* alpha_w; const float* alpha_b; const float* gnw; const float* w_branch; const float* w_out; const float* fnw; float* out; unsigned char* ws; };

__global__ void __launch_bounds__(512, 2) fwd_megakernel(Args a) {
    extern __shared__ __attribute__((aligned(16))) unsigned char lds_raw[];
    LAS unsigned char* lds = (LAS unsigned char*)lds_raw;
    cg::grid_group grid = cg::this_grid();
    const int tid = threadIdx.x, lane = tid & 63, wave = __builtin_amdgcn_readfirstlane(tid >> 6);
    const int G = gridDim.x, bid = blockIdx.x;
    const int gw = bid * 8 + wave, NGW = G * 8;
    unsigned char* ws = a.ws;
    float* mod = (float*)(ws + WS_MOD); float* lbv = (float*)(ws + WS_LB); float* SS = (float*)(ws + WS_SS); float* DSC = (float*)(ws + WS_DSC);
    bf16_t* D1 = (bf16_t*)(ws + WS_D1); bf16_t* P = (bf16_t*)(ws + WS_P);
    bf16_t* H = (bf16_t*)((unsigned char*)a.out + OUT_H); float* ST = (float*)((unsigned char*)a.out + OUT_ST);

    for (int jb = bid; jb < 192; jb += G) {
        LAS float* cact = (LAS float*)lds; LAS float* red = cact + 2048;
        for (int i = tid; i < 2048; i += 512) { const float v = a.c[i]; cact[i] = v * fsigmoid(v); }
        __syncthreads();
        const int l = jb / 96, j0 = (jb % 96) * 32, jj = tid & 31, seg = tid >> 5;
        const float* wp = a.ada_w + (size_t)l * 1024 * 3072 + j0 + jj;
        float a0 = 0.f, a1 = 0.f;
#pragma unroll 8
        for (int i = seg * 64; i < seg * 64 + 64; ++i) { const float wv = wp[(size_t)i * 3072]; a0 += cact[i] * wv; a1 += cact[1024 + i] * wv; }
        red[(seg * 32 + jj) * 2] = a0; red[(seg * 32 + jj) * 2 + 1] = a1;
        __syncthreads();
        if (tid < 64) { const int j2 = tid & 31, b = tid >> 5; float s = 0.f;
#pragma unroll
            for (int sg = 0; sg < 16; ++sg) s += red[(sg * 32 + j2) * 2 + b];
            mod[(l * 2 + b) * 3072 + j0 + j2] = s + a.ada_b[l * 3072 + j0 + j2]; }
        __syncthreads();
    }
    for (int j = bid * 512 + tid; j < 1024; j += G * 512) {
        const float l0 = a.lb_logits[j], l1 = a.lb_logits[1024 + j], mx = fmaxf(l0, l1), e0 = __expf(l0 - mx), e1 = __expf(l1 - mx);
        const float p0 = e0 / (e0 + e1), p1 = e1 / (e0 + e1);
        lbv[j] = 0.f; lbv[1024 + j] = fminf(fmaxf((p0 + p1) - p0, 0.f), 1.f);
    }
    {
        LAS float* scr = (LAS float*)(lds + wave * 8448);
        for (int it = gw; it < 2 * 6400; it += NGW) {
            const int l = it / 6400; int r = it % 6400;
            bf16_t* WT = (bf16_t*)(ws + WS_W + (size_t)l * W_LAYER);
            const float* win = a.w_in + (size_t)l * 1024 * DIN;
            if (r < 1536) { tr_item(win, DIN, 0, WT, 0, scr, r, 96, lane); continue; } r -= 1536;
            if (r < 1024) { tr_item(win, DIN, 4096, WT, 3072, scr, r, 64, lane); continue; } r -= 1024;
            if (r < 256) { tr_item_la(win, a.alpha_w + (size_t)l * 16 * 512, WT, 5120, scr, r, lane); continue; } r -= 256;
            if (r < 512) { tr_item(win, DIN, 3072, WT, 5632, scr, r, 32, lane); continue; } r -= 512;
            if (r < 512) { tr_item(win, DIN, 6144, WT, 6656, scr, r, 32, lane); continue; } r -= 512;
            if (r < 1024) { tr_item(win, DIN, 7184, WT, 7680, scr, r, 64, lane); continue; } r -= 1024;
            if (r < 512) { tr_item(a.w_branch + (size_t)l * 2 * 1048576, 1024, 0, WT, 9728, scr, r, 32, lane); continue; } r -= 512;
            if (r < 512) { tr_item(a.w_branch + (size_t)l * 2 * 1048576 + 1048576, 1024, 0, WT, 10752, scr, r, 32, lane); continue; } r -= 512;
            tr_item(a.w_out + (size_t)l * 1048576, 1024, 0, WT, 11776, scr, r, 32, lane);
        }
    }
    grid.sync();

#pragma unroll 1
    for (int l = 0; l < 2; ++l) {
        const bf16_t* WT = (const bf16_t*)(ws + WS_W + (size_t)l * W_LAYER);
        const float* modl = mod + l * 2 * 3072;
        { const int tid = opaque_tid(), lane = tid & 63, wave = __builtin_amdgcn_readfirstlane(tid >> 6), gw = bid * 8 + wave;
        for (int i = bid * 512 + tid; i < MROWS * 8; i += G * 512) SS[i] = 0.f;
        for (int m = gw; m < MROWS; m += NGW) {
            const int b = m >> 13;
            const f32x4* xr = (const f32x4*)(a.x + (size_t)m * DM) + lane;
            f32x4 v[4]; float s = 0.f;
#pragma unroll
            for (int j = 0; j < 4; ++j) v[j] = xr[64 * j];
            if (l == 1) { const u32x2* dr = (const u32x2*)(D1 + (size_t)m * DM) + lane;
#pragma unroll
                for (int j = 0; j < 4; ++j) { const u32x2 d = dr[64 * j]; v[j][0] += bf_lo(d.x); v[j][1] += bf_hi(d.x); v[j][2] += bf_lo(d.y); v[j][3] += bf_hi(d.y); } }
#pragma unroll
            for (int j = 0; j < 4; ++j) s += (v[j][0] * v[j][0] + v[j][1] * v[j][1]) + (v[j][2] * v[j][2] + v[j][3] * v[j][3]);
            const float rstd = rsqrtf(wave_sum(s) * (1.f / 1024.f) + EPS);
            const float* mb = modl + b * 3072; const float* nw = a.norm_w + l * 1024;
            u32x2* hr = (u32x2*)(H + (size_t)m * DM) + lane;
#pragma unroll
            for (int j = 0; j < 4; ++j) { const int col = 4 * lane + 256 * j;
                const f32x4 nv = *(const f32x4*)(nw + col), sh = *(const f32x4*)(mb + col), sc = *(const f32x4*)(mb + 1024 + col);
                const f32x4 h = v[j] * rstd * nv * (sc + 1.f) + sh;
                u32x2 o; o.x = cvt_pk_bf16(h[0], h[1]); o.y = cvt_pk_bf16(h[2], h[3]); hr[64 * j] = o; }
        } }
        grid.sync();
        { pg8::Gemm g{H, WT, 1024, 1024}; pg8::StaticOrder S; S.init(MROWS, 5632, G, bid);
          EpiA1 E{P, lbv + l * 1024, a.alpha_b + l * 512};
          pg8::gemm_phase<EpiA1, pg8::StaticOrder>(lds, g, S, E); }
        grid.sync();
        for (int item = bid; item < 512; item += G) la_item<false>(lds, P, ST, DSC, SS, item);
        grid.sync();
        for (int gt = bid * 512 + opaque_tid(); gt < 32 * 4096; gt += G * 512) {
            const int chain = gt >> 12, e = gt & 4095, k = e >> 5;
            f32x4 carry = (f32x4){0.f, 0.f, 0.f, 0.f};
#pragma unroll 4
            for (int sc = 0; sc < 16; ++sc) { const int item = chain * 16 + sc; f32x4* p = (f32x4*)(ST + (size_t)item * 16384) + e;
                const f32x4 cur = *p; *p = carry; const float d = DSC[(size_t)item * 128 + k]; carry = carry * d + cur; }
        }
        grid.sync();
        for (int item = bid; item < 512; item += G) la_item<true>(lds, P, ST, DSC, SS, item);
        grid.sync();
        { pg8::Gemm g{H, WT + (size_t)5632 * 1024, 1024, 1024}; pg8::StaticOrder S; S.init(MROWS, 4096, G, bid);
          EpiA2 E{P, SS, a.hnw + l * 1024, a.gnw + l * 256};
          pg8::gemm_phase<EpiA2, pg8::StaticOrder>(lds, g, S, E); }
        grid.sync();
        { pg8::Gemm g{P, WT + (size_t)9728 * 1024, LDP, 1024}; pg8::BranchOrder S; S.s.init(MROWS, 1024, G, bid);
          EpiC1 E{P};
          pg8::gemm_phase<EpiC1, pg8::BranchOrder>(lds, g, S, E); }
        grid.sync();
        { pg8::Gemm g{P + 3072, WT + (size_t)11776 * 1024, LDP, 1024}; pg8::StaticOrder S; S.init(MROWS, 1024, G, bid);
          if (l == 0) { EpiC2a E{D1, modl}; pg8::gemm_phase<EpiC2a, pg8::StaticOrder>(lds, g, S, E); }
          else { EpiC2b E{a.x, D1, a.out, modl}; pg8::gemm_phase<EpiC2b, pg8::StaticOrder>(lds, g, S, E); } }
        grid.sync();
    }
    for (int m = gw; m < MROWS; m += NGW) {
        f32x4* xr = (f32x4*)(a.out + (size_t)m * DM) + lane;
        f32x4 v[4]; float s = 0.f;
#pragma unroll
        for (int j = 0; j < 4; ++j) { v[j] = xr[64 * j]; s += (v[j][0] * v[j][0] + v[j][1] * v[j][1]) + (v[j][2] * v[j][2] + v[j][3] * v[j][3]); }
        const float rstd = rsqrtf(wave_sum(s) * (1.f / 1024.f) + EPS);
#pragma unroll
        for (int j = 0; j < 4; ++j) { const f32x4 nv = *(const f32x4*)(a.fnw + 4 * lane + 256 * j); xr[64 * j] = v[j] * rstd * nv; }
    }
}

extern "C" void kernel_launch(void* const* d_in, const int* in_sizes, int n_in, void* d_out, int out_size, void* d_ws, size_t ws_size, hipStream_t stream) {
    static int grid = 0;
    if (grid == 0) {
        if (n_in != 14 || out_size != MROWS * DM || ws_size < WS_END) { fprintf(stderr, "kernel_launch: unexpected problem (n_in %d, out %d, ws %zu < %zu)\n", n_in, out_size, ws_size, (size_t)WS_END); grid = -1; return; }
        int dev = 0, cus = 0, per_cu = 0;
        if (hipGetDevice(&dev) != hipSuccess || hipDeviceGetAttribute(&cus, hipDeviceAttributeMultiprocessorCount, dev) != hipSuccess) { grid = -1; return; }
        if (hipFuncSetAttribute((const void*)fwd_megakernel, hipFuncAttributeMaxDynamicSharedMemorySize, LDS_BYTES) != hipSuccess) { fprintf(stderr, "kernel_launch: hipFuncSetAttribute failed\n"); grid = -1; return; }
        if (hipOccupancyMaxActiveBlocksPerMultiprocessor(&per_cu, (const void*)fwd_megakernel, 512, LDS_BYTES) != hipSuccess || per_cu < 1) { fprintf(stderr, "kernel_launch: occupancy query says %d\n", per_cu); grid = -1; return; }
        grid = cus;
    }
    if (grid < 0) return;
    Args a{};
    a.x = (const float*)d_in[0]; a.c = (const float*)d_in[1]; a.ada_w = (const float*)d_in[2]; a.ada_b = (const float*)d_in[3]; a.norm_w = (const float*)d_in[4]; a.w_in = (const float*)d_in[5];
    a.lb_logits = (const float*)d_in[6]; a.hnw = (const float*)d_in[7]; a.alpha_w = (const float*)d_in[8]; a.alpha_b = (const float*)d_in[9]; a.gnw = (const float*)d_in[10];
    a.w_branch = (const float*)d_in[11]; a.w_out = (const float*)d_in[12]; a.fnw = (const float*)d_in[13]; a.out = (float*)d_out; a.ws = (unsigned char*)d_ws;
    void* args[] = {&a};
    const hipError_t e = hipLaunchCooperativeKernel((const void*)fwd_megakernel, dim3(grid), dim3(512), args, LDS_BYTES, stream);
    if (e != hipSuccess) fprintf(stderr, "kernel_launch: cooperative launch failed: %s (grid %d)\n", hipGetErrorString(e), grid);
}
```

```cpp
#include <hip/hip_runtime.h>
#include <hip/hip_cooperative_groups.h>
#include <cstdio>
#include <cstdint>
namespace cg = cooperative_groups;

#define LAS __attribute__((address_space(3)))
typedef unsigned short bf16_t;
typedef short bf16x8 __attribute__((ext_vector_type(8)));
typedef float f32x4 __attribute__((ext_vector_type(4)));
typedef float f32x2 __attribute__((ext_vector_type(2)));
typedef unsigned u32x4 __attribute__((ext_vector_type(4)));
typedef unsigned u32x2 __attribute__((ext_vector_type(2)));

constexpr int MROWS = 16384, DM = 1024, SEQ = 8192, LDP = 5632, DIN = 9232;
constexpr float EPS = 1e-6f;
constexpr size_t WS_MOD = 4096, WS_LB = 53248, WS_SS = 65536, WS_DSC = 589824, WS_BAR = 860160, WS_W = 1048576, W_LAYER = 26214400;
constexpr size_t WS_D1 = WS_W + 2 * W_LAYER, WS_P = WS_D1 + (size_t)MROWS * DM * 2, WS_END = WS_P + (size_t)MROWS * LDP * 2;
constexpr size_t OUT_H = 0, OUT_ST = 33554432;
constexpr int LDS_BYTES = 147456, L_BARST = 146432;

__device__ __forceinline__ unsigned cvt_pk_bf16(float lo, float hi) { unsigned r; asm volatile("v_cvt_pk_bf16_f32 %0, %1, %2" : "=v"(r) : "v"(lo), "v"(hi)); return r; }
__device__ __forceinline__ float bf_lo(unsigned w) { return __uint_as_float(w << 16); }
__device__ __forceinline__ float bf_hi(unsigned w) { return __uint_as_float(w & 0xffff0000u); }
__device__ __forceinline__ float fsigmoid(float v) { return __builtin_amdgcn_rcpf(1.f + __expf(-v)); }
__device__ __forceinline__ int opaque_tid() { int t = threadIdx.x; asm volatile("" : "+v"(t)); return t; }
__device__ __forceinline__ float wave_sum(float v) {
#pragma unroll
    for (int o = 1; o < 64; o <<= 1) v += __shfl_xor(v, o);
    return v;
}

namespace pg8 {
constexpr int BM = 256, BK = 64, HALF = 128, HTB = HALF * BK * 2, STAGE_BYTES = 8 * HTB, NXCD = 8, WGM = 8;
__host__ __device__ __forceinline__ int lds_byte(int r, int c) { const int st = (r >> 4) * 2 + (c >> 5), rr = r & 15, cc = c & 31, ob = rr * 64 + cc * 2; return st * 1024 + (ob ^ (((ob >> 9) & 1) << 5)); }
__host__ __device__ __forceinline__ void stage_rc(int b, int& R, int& C) { const int st = b / 1024, sb = b % 1024, swz = sb ^ (((sb >> 9) & 1) << 5); R = (st >> 1) * 16 + swz / 64; C = (st & 1) * 32 + (swz % 64) / 2; }
__host__ __device__ __forceinline__ int perm32(int rho) { const int n = rho >> 4, i = rho & 15; return 8 * (i >> 2) + 4 * n + (i & 3); }

struct Unit { int pm, pn, br; unsigned ao, bo; };
struct Gemm { const bf16_t* A; const bf16_t* Bt; int lda, K; };

struct StaticOrder {
    int nM, nN, nwg, G, c;
    __host__ __device__ void init(int M, int N, int G_, int c_) { nM = M / BM; nN = N / BM; nwg = nM * nN; G = G_; c = c_; }
    __host__ __device__ bool next(int i, Unit& u) const {
        const long L = (long)i * G + c; if (L >= nwg) return false;
        int wgid = (int)L; { const int q = nwg / NXCD, r = nwg % NXCD, xcd = wgid % NXCD, off = wgid / NXCD; wgid = (xcd < r ? xcd * (q + 1) : r * (q + 1) + (xcd - r) * q) + off; }
        const int nig = WGM * nN, gid = wgid / nig, fm = gid * WGM, gsz = (nM - fm) < WGM ? (nM - fm) : WGM;
        u.pm = fm + ((wgid % nig) % gsz); u.pn = (wgid % nig) / gsz; u.br = 0; u.ao = 0u; u.bo = 0u; return true;
    }
};
struct BranchOrder {
    StaticOrder s;
    __host__ __device__ bool next(int i, Unit& u) const { if (!s.next(i >> 1, u)) return false; u.br = i & 1; u.ao = (i & 1) ? 4096u * 2u : 0u; u.bo = (i & 1) ? 1024u * 1024u * 2u : 0u; return true; }
};

template <class Epi, class Sched>
__device__ __forceinline__ void gemm_phase(LAS unsigned char* lds, const Gemm g, const Sched& S, const Epi& E) {
    const int tid = opaque_tid(), wid = __builtin_amdgcn_readfirstlane(tid >> 6), lane = tid & 63, wr = wid >> 2, wc = wid & 3, fr = lane & 15, fq = lane >> 4;
    const int K = g.K, nt = K / BK, lda = g.lda;
    unsigned voffA[2], voffB[2];
#pragma unroll
    for (int i = 0; i < 2; ++i) { int R, C; stage_rc(tid * 16 + i * 8192, R, C); const int Rb = Epi::PERM ? ((R & ~31) + perm32(R & 31)) : R;
        voffA[i] = (unsigned)(R * lda + C) * 2u; voffB[i] = (unsigned)(Rb * K + C) * 2u;
        asm volatile("" : "+v"(voffA[i]), "+v"(voffB[i])); }
    const size_t kstep = (size_t)(BK * 2);
    const size_t hA = (size_t)HALF * lda * 2, tA = 2 * hA, hB = (size_t)HALF * K * 2, tB = 2 * hB;
    const unsigned ldsw = (unsigned)wid * 1024u;
    const int aoff = lds_byte(wr * 64 + fr, fq * 8), boff = lds_byte(wc * 32 + fr, fq * 8);
#define PG8_SA(b, h) (((b) * 2 + (h)) * HTB)
#define PG8_SB(b, h) ((4 + (b) * 2 + (h)) * HTB)
#define PG8_STAGE(bufoff, gbase, voff) do { _Pragma("unroll") for (int _i = 0; _i < 2; ++_i) \
        __builtin_amdgcn_global_load_lds((const unsigned*)((const char*)(gbase) + (voff)[_i]), (LAS unsigned*)(lds + (bufoff) + ldsw + _i * 8192), 16, 0, 0); } while (0)
#define PG8_LDA(dst, b, h) do { _Pragma("unroll") for (int m = 0; m < 4; ++m) _Pragma("unroll") for (int k = 0; k < 2; ++k) dst[m][k] = *(const LAS bf16x8*)(lds + PG8_SA(b, h) + aoff + m * 2048 + k * 1024); } while (0)
#define PG8_LDB(dst, b, h) do { _Pragma("unroll") for (int n = 0; n < 2; ++n) _Pragma("unroll") for (int k = 0; k < 2; ++k) dst[n][k] = *(const LAS bf16x8*)(lds + PG8_SB(b, h) + boff + n * 2048 + k * 1024); } while (0)
#define PG8_MMA(ai, bj, At, Bt) do { __builtin_amdgcn_s_setprio(1); _Pragma("unroll") for (int m = 0; m < 4; ++m) _Pragma("unroll") for (int n = 0; n < 2; ++n) _Pragma("unroll") for (int k = 0; k < 2; ++k) \
        acc[ai][bj][m][n] = __builtin_amdgcn_mfma_f32_16x16x32_bf16(Bt[n][k], At[m][k], acc[ai][bj][m][n], 0, 0, 0); __builtin_amdgcn_s_setprio(0); } while (0)
#define PG8_WAIT_V(n) asm volatile("s_waitcnt vmcnt(" #n ")" ::: "memory")
#define PG8_WAIT_L(n) asm volatile("s_waitcnt lgkmcnt(" #n ")" ::: "memory")
#define PG8_BAR __builtin_amdgcn_s_barrier()
#define PG8_SCHED __builtin_amdgcn_sched_barrier(0)
    Unit cur, nxt; int ui = 0;
    if (!S.next(0, cur)) return;
    f32x4 acc[2][2][4][2];
#pragma unroll
    for (int a = 0; a < 2; ++a)
#pragma unroll
        for (int b = 0; b < 2; ++b)
#pragma unroll
            for (int m = 0; m < 4; ++m)
#pragma unroll
                for (int n = 0; n < 2; ++n) acc[a][b][m][n] = (f32x4){0.f, 0.f, 0.f, 0.f};
    bf16x8 At[4][2], B0[2][2], B1[2][2];
    const char* cA = (const char*)g.A + (size_t)cur.pm * tA + cur.ao; const char* cB = (const char*)g.Bt + (size_t)cur.pn * tB + cur.bo;
    PG8_STAGE(PG8_SB(0, 0), cB, voffB); PG8_STAGE(PG8_SB(0, 1), cB + hB, voffB); PG8_STAGE(PG8_SA(0, 0), cA, voffA); PG8_STAGE(PG8_SA(0, 1), cA + hA, voffA);
    if (wr == 1) PG8_BAR;
    PG8_WAIT_V(2); PG8_BAR;
    PG8_STAGE(PG8_SB(1, 0), cB + kstep, voffB); PG8_STAGE(PG8_SA(1, 0), cA + kstep, voffA); PG8_STAGE(PG8_SB(1, 1), cB + hB + kstep, voffB);
    PG8_WAIT_V(6); PG8_BAR;
    for (;;) {
        const bool has_next = S.next(ui + 1, nxt);
        const char* nA = has_next ? (const char*)g.A + (size_t)nxt.pm * tA + nxt.ao : cA; const char* nB = has_next ? (const char*)g.Bt + (size_t)nxt.pn * tB + nxt.bo : cB;
        for (int t = 0; t < nt; t += 2) {
            const bool last = (t == nt - 2);
            const char* a1 = cA + (size_t)(t + 1) * kstep;
            const char* a2 = last ? nA : cA + (size_t)(t + 2) * kstep; const char* b2 = last ? nB : cB + (size_t)(t + 2) * kstep;
            const char* a3 = a2 + kstep; const char* b3 = b2 + kstep;
            PG8_LDB(B0, 0, 0); PG8_LDB(B1, 0, 1); PG8_SCHED; PG8_LDA(At, 0, 0); PG8_STAGE(PG8_SA(1, 1), a1 + hA, voffA);
            PG8_WAIT_V(8); PG8_WAIT_L(0); PG8_BAR; PG8_MMA(0, 0, At, B0); PG8_MMA(0, 1, At, B1); PG8_BAR; PG8_SCHED;
            PG8_LDA(At, 0, 1); PG8_STAGE(PG8_SB(0, 0), b2, voffB); PG8_STAGE(PG8_SB(0, 1), b2 + hB, voffB); PG8_STAGE(PG8_SA(0, 0), a2, voffA);
            PG8_WAIT_V(8); PG8_WAIT_L(0); PG8_BAR; PG8_MMA(1, 0, At, B0); PG8_MMA(1, 1, At, B1); PG8_BAR; PG8_SCHED;
            PG8_LDB(B0, 1, 0); PG8_LDB(B1, 1, 1); PG8_SCHED; PG8_LDA(At, 1, 0); PG8_STAGE(PG8_SA(0, 1), a2 + hA, voffA);
            PG8_WAIT_V(8); PG8_WAIT_L(0); PG8_BAR; PG8_MMA(0, 0, At, B0); PG8_MMA(0, 1, At, B1); PG8_BAR; PG8_SCHED;
            PG8_LDA(At, 1, 1); PG8_STAGE(PG8_SB(1, 0), b3, voffB); PG8_STAGE(PG8_SB(1, 1), b3 + hB, voffB); PG8_STAGE(PG8_SA(1, 0), a3, voffA);
            PG8_WAIT_V(8); PG8_WAIT_L(0); PG8_BAR; PG8_MMA(1, 0, At, B0); PG8_MMA(1, 1, At, B1); PG8_BAR; PG8_SCHED;
        }
        if (wr == 0) PG8_BAR;
        E(acc, cur, wr, wc, fr, fq);
        if (!has_next) break;
#pragma unroll
        for (int a = 0; a < 2; ++a)
#pragma unroll
            for (int b = 0; b < 2; ++b)
#pragma unroll
                for (int m = 0; m < 4; ++m)
#pragma unroll
                    for (int n = 0; n < 2; ++n) acc[a][b][m][n] = (f32x4){0.f, 0.f, 0.f, 0.f};
        cur = nxt; cA = nA; cB = nB; ++ui;
        if (wr == 1) PG8_BAR;
    }
    PG8_WAIT_V(0);
    PG8_BAR;
#undef PG8_SA
#undef PG8_SB
#undef PG8_STAGE
#undef PG8_LDA
#undef PG8_LDB
#undef PG8_MMA
#undef PG8_WAIT_V
#undef PG8_WAIT_L
#undef PG8_BAR
#undef PG8_SCHED
}
}
using pg8::Unit;

__device__ __forceinline__ void unpack8(const u32x4 w, float (&o)[8]) { o[0] = bf_lo(w.x); o[1] = bf_hi(w.x); o[2] = bf_lo(w.y); o[3] = bf_hi(w.y); o[4] = bf_lo(w.z); o[5] = bf_hi(w.z); o[6] = bf_lo(w.w); o[7] = bf_hi(w.w); }
__device__ __forceinline__ u32x4 pack8(const float (&v)[8]) { u32x4 w; w.x = cvt_pk_bf16(v[0], v[1]); w.y = cvt_pk_bf16(v[2], v[3]); w.z = cvt_pk_bf16(v[4], v[5]); w.w = cvt_pk_bf16(v[6], v[7]); return w; }

struct EpiA1 {
    static constexpr bool PERM = true;
    bf16_t* P; const float* lb; const float* ab;
    __device__ __forceinline__ void operator()(const f32x4 (&acc)[2][2][4][2], const Unit& u, int wr, int wc, int fr, int fq) const {
        const int pn = u.pn;
        const int type = pn < 4 ? 0 : pn < 8 ? 1 : pn < 12 ? 2 : pn < 14 ? 3 : pn < 20 ? 2 : 4;
        const int row0 = u.pm * 256 + wr * 64 + fr, colb = pn * 256 + wc * 32 + 8 * fq;
#pragma unroll
        for (int bj = 0; bj < 2; ++bj) {
            const int col = colb + bj * 128;
            float pr[8];
#pragma unroll
            for (int e = 0; e < 8; ++e) pr[e] = 0.f;
            if (type == 1) { const f32x4 p0 = *(const f32x4*)(lb + col - 1024), p1 = *(const f32x4*)(lb + col - 1024 + 4); pr[0] = p0[0]; pr[1] = p0[1]; pr[2] = p0[2]; pr[3] = p0[3]; pr[4] = p1[0]; pr[5] = p1[1]; pr[6] = p1[2]; pr[7] = p1[3]; }
            if (type == 4) { const f32x4 p0 = *(const f32x4*)(ab + col - 5120), p1 = *(const f32x4*)(ab + col - 5120 + 4); pr[0] = p0[0]; pr[1] = p0[1]; pr[2] = p0[2]; pr[3] = p0[3]; pr[4] = p1[0]; pr[5] = p1[1]; pr[6] = p1[2]; pr[7] = p1[3]; }
#pragma unroll
            for (int ai = 0; ai < 2; ++ai)
#pragma unroll
                for (int m = 0; m < 4; ++m) {
                    const int row = row0 + ai * 128 + m * 16;
                    float v[8];
#pragma unroll
                    for (int e = 0; e < 4; ++e) { v[e] = acc[ai][bj][m][0][e]; v[4 + e] = acc[ai][bj][m][1][e]; }
                    if (type == 0) {
#pragma unroll
                        for (int e = 0; e < 8; ++e) v[e] = v[e] * fsigmoid(v[e]);
                    } else if (type == 1) {
#pragma unroll
                        for (int e = 0; e < 8; ++e) { const float f = pr[e] + (1.f - pr[e]) * fsigmoid(v[e]); v[e] = __logf(fmaxf(f, 1e-20f)); }
                    } else if (type == 3) {
#pragma unroll
                        for (int e = 0; e < 8; ++e) v[e] *= 0.08838834764831845f;
                    } else if (type == 4) {
#pragma unroll
                        for (int e = 0; e < 8; ++e) { const float z = v[e] + pr[e]; v[e] = (fminf(z, 0.f) - __logf(1.f + __expf(-fabsf(z)))) * 0.0625f; }
                    }
                    *(u32x4*)(P + (size_t)row * LDP + col) = pack8(v);
                }
        }
    }
};
struct EpiA2 {
    static constexpr bool PERM = true;
    bf16_t* P; const float* SS; const float* hnw; const float* gnw;
    __device__ __forceinline__ void operator()(const f32x4 (&acc)[2][2][4][2], const Unit& u, int wr, int wc, int fr, int fq) const {
        const int pn = u.pn;
        const int row0 = u.pm * 256 + wr * 64 + fr, cw = wc * 32 + 8 * fq;
#pragma unroll
        for (int bj = 0; bj < 2; ++bj) {
            const int cin = cw + bj * 128;
            float nw[8];
#pragma unroll
            for (int e = 0; e < 8; ++e) nw[e] = 1.f;
            int dcol;
            if (pn < 4) { dcol = pn * 256 + cin; const f32x4 p0 = *(const f32x4*)(hnw + dcol), p1 = *(const f32x4*)(hnw + dcol + 4); nw[0] = p0[0]; nw[1] = p0[1]; nw[2] = p0[2]; nw[3] = p0[3]; nw[4] = p1[0]; nw[5] = p1[1]; nw[6] = p1[2]; nw[7] = p1[3]; }
            else if (pn < 8) { dcol = 4096 + (pn - 4) * 256 + cin; const f32x4 p0 = *(const f32x4*)(gnw + cin), p1 = *(const f32x4*)(gnw + cin + 4); nw[0] = p0[0]; nw[1] = p0[1]; nw[2] = p0[2]; nw[3] = p0[3]; nw[4] = p1[0]; nw[5] = p1[1]; nw[6] = p1[2]; nw[7] = p1[3]; }
            else dcol = 1024 + (pn - 8) * 256 + cin;
#pragma unroll
            for (int ai = 0; ai < 2; ++ai)
#pragma unroll
                for (int m = 0; m < 4; ++m) {
                    const int row = row0 + ai * 128 + m * 16;
                    float v[8];
#pragma unroll
                    for (int e = 0; e < 4; ++e) { v[e] = acc[ai][bj][m][0][e]; v[4 + e] = acc[ai][bj][m][1][e]; }
                    bf16_t* dst = P + (size_t)row * LDP + dcol;
                    if (pn < 8) {
                        const float ssv = (pn < 4) ? SS[row * 8] : SS[row * 8 + 1 + (pn - 4)];
                        const float rstd = rsqrtf(ssv * ((pn < 4) ? (1.f / 1024.f) : (1.f / 256.f)) + EPS);
                        float o[8]; unpack8(*(const u32x4*)dst, o);
#pragma unroll
                        for (int e = 0; e < 8; ++e) v[e] = o[e] * rstd * nw[e] * (v[e] * fsigmoid(v[e]));
                    } else {
#pragma unroll
                        for (int e = 0; e < 8; ++e) v[e] = fsigmoid(v[e]);
                    }
                    *(u32x4*)dst = pack8(v);
                }
        }
    }
};
struct EpiC1 {
    static constexpr bool PERM = true;
    bf16_t* P;
    __device__ __forceinline__ void operator()(const f32x4 (&acc)[2][2][4][2], const Unit& u, int wr, int wc, int fr, int fq) const {
        const int br = u.br;
        const int row0 = u.pm * 256 + wr * 64 + fr, colb = u.pn * 256 + wc * 32 + 8 * fq;
#pragma unroll
        for (int bj = 0; bj < 2; ++bj) {
            const int c = colb + bj * 128;
#pragma unroll
            for (int ai = 0; ai < 2; ++ai)
#pragma unroll
                for (int m = 0; m < 4; ++m) {
                    const int row = row0 + ai * 128 + m * 16;
                    float v[8], gt[8];
#pragma unroll
                    for (int e = 0; e < 4; ++e) { v[e] = acc[ai][bj][m][0][e]; v[4 + e] = acc[ai][bj][m][1][e]; }
                    bf16_t* rp = P + (size_t)row * LDP;
                    unpack8(*(const u32x4*)(rp + 1024 + 1024 * br + c), gt);
#pragma unroll
                    for (int e = 0; e < 8; ++e) v[e] *= gt[e];
                    if (br) { float o[8]; unpack8(*(const u32x4*)(rp + 3072 + c), o);
#pragma unroll
                        for (int e = 0; e < 8; ++e) v[e] += o[e]; }
                    *(u32x4*)(rp + 3072 + c) = pack8(v);
                }
        }
    }
};
struct EpiC2a {
    static constexpr bool PERM = true;
    bf16_t* D1; const float* mod;
    __device__ __forceinline__ void operator()(const f32x4 (&acc)[2][2][4][2], const Unit& u, int wr, int wc, int fr, int fq) const {
        const int row0 = u.pm * 256 + wr * 64 + fr, colb = u.pn * 256 + wc * 32 + 8 * fq;
        const float* gp = mod + (u.pm >> 5) * 3072 + 2048;
#pragma unroll
        for (int bj = 0; bj < 2; ++bj) {
            const int c = colb + bj * 128;
            const f32x4 g0 = *(const f32x4*)(gp + c), g1 = *(const f32x4*)(gp + c + 4);
#pragma unroll
            for (int ai = 0; ai < 2; ++ai)
#pragma unroll
                for (int m = 0; m < 4; ++m) {
                    const int row = row0 + ai * 128 + m * 16;
                    float v[8];
#pragma unroll
                    for (int e = 0; e < 4; ++e) { v[e] = acc[ai][bj][m][0][e] * g0[e]; v[4 + e] = acc[ai][bj][m][1][e] * g1[e]; }
                    *(u32x4*)(D1 + (size_t)row * DM + c) = pack8(v);
                }
        }
    }
};
struct EpiC2b {
    static constexpr bool PERM = false;
    const float* x; const bf16_t* D1; float* out; const float* mod;
    __device__ __forceinline__ void operator()(const f32x4 (&acc)[2][2][4][2], const Unit& u, int wr, int wc, int fr, int fq) const {
        const int row0 = u.pm * 256 + wr * 64 + fr, colb = u.pn * 256 + wc * 32 + 4 * fq;
        const float* gp = mod + (u.pm >> 5) * 3072 + 2048;
#pragma unroll
        for (int bj = 0; bj < 2; ++bj)
#pragma unroll
            for (int n = 0; n < 2; ++n) {
                const int c = colb + bj * 128 + n * 16;
                const f32x4 gv = *(const f32x4*)(gp + c);
#pragma unroll
                for (int ai = 0; ai < 2; ++ai)
#pragma unroll
                    for (int m = 0; m < 4; ++m) {
                        const size_t off = (size_t)(row0 + ai * 128 + m * 16) * DM + c;
                        const f32x4 xv = *(const f32x4*)(x + off); const u32x2 d = *(const u32x2*)(D1 + off);
                        f32x4 o = xv + acc[ai][bj][m][n] * gv; o[0] += bf_lo(d.x); o[1] += bf_hi(d.x); o[2] += bf_lo(d.y); o[3] += bf_hi(d.y);
                        *(f32x4*)(out + off) = o;
                    }
            }
    }
};

__device__ __forceinline__ unsigned f2bf(float f) { unsigned u = __float_as_uint(f); return (u + 0x7fffu + ((u >> 16) & 1u)) >> 16; }
__device__ __forceinline__ unsigned pk2(float lo, float hi) { return f2bf(lo) | (f2bf(hi) << 16); }
__device__ __forceinline__ void tr_write(bf16_t* WT, int row_off, int n0, int k0, LAS float* scr, int lane) {
    asm volatile("s_waitcnt lgkmcnt(0)" ::: "memory");
    const int c = lane & 7;
#pragma unroll
    for (int j = 0; j < 4; ++j) { const int n = (lane >> 3) + 8 * j; const LAS float* s = scr + (8 * c) * 33 + n;
        u32x4 o; o.x = pk2(s[0 * 33], s[1 * 33]); o.y = pk2(s[2 * 33], s[3 * 33]); o.z = pk2(s[4 * 33], s[5 * 33]); o.w = pk2(s[6 * 33], s[7 * 33]);
        *(u32x4*)(WT + (size_t)(row_off + n0 + n) * 1024 + k0 + 8 * c) = o; }
    asm volatile("s_waitcnt lgkmcnt(0)" ::: "memory");
}
__device__ __forceinline__ void tr_item(const float* W, int ldw, int col0, bf16_t* WT, int row_off, LAS float* scr, int item, int nblk, int lane) {
    const int kb = item / nblk, nb = item % nblk, k0 = 64 * kb, n0 = 32 * nb;
#pragma unroll 8
    for (int i = 0; i < 32; ++i) { const int kk = 2 * i + (lane >> 5); scr[kk * 33 + (lane & 31)] = W[(size_t)(k0 + kk) * ldw + col0 + n0 + (lane & 31)]; }
    tr_write(WT, row_off, n0, k0, scr, lane);
}
__device__ __forceinline__ void tr_item_la(const float* win, const float* aw, bf16_t* WT, int row_off, LAS float* scr, int item, int lane) {
    const int kb = item / 16, nb = item % 16, k0 = 64 * kb, n0 = 32 * nb;
    float awr[16];
#pragma unroll
    for (int r = 0; r < 16; ++r) awr[r] = aw[r * 512 + n0 + (lane & 31)];
#pragma unroll 4
    for (int i = 0; i < 32; ++i) { const int kk = 2 * i + (lane >> 5); const float* wr_ = win + (size_t)(k0 + kk) * DIN + 7168; float s = 0.f;
#pragma unroll
        for (int r = 0; r < 16; ++r) s += wr_[r] * awr[r];
        scr[kk * 33 + (lane & 31)] = s; }
    tr_write(WT, row_off, n0, k0, scr, lane);
}

constexpr int L_RAWQ = 0, L_RAWK = 16384, L_RAWG = 32768, L_RAWV = 49152;
constexpr int L_ST = 0, L_PB = 36864;
constexpr int L_QM = 65536, L_KM = 82944, L_KET = 100352, L_VT = 118784;
constexpr int L_PSUM = 137216, L_EBREF = 141312, L_EBLAST = 141824, L_RED = 142336;
static_assert(L_RED + 2048 <= LDS_BYTES, "LDS map");

template <bool OUT>
__device__ __forceinline__ void la_item(LAS unsigned char* lds, bf16_t* P, float* ST, float* DSC, float* SS, int item) {
    const int tid = opaque_tid();
    const int lane = tid & 63, w = __builtin_amdgcn_readfirstlane(tid >> 6), fr = lane & 15, fq = lane >> 4;
    const int sc = item & 15, vh = (item >> 4) & 15, b = item >> 8;
    const int row0 = b * SEQ + sc * 512;
    int qcol, kcol, gcol, vcol, sscol;
    if (vh < 8) { qcol = 128 * vh; kcol = -1; gcol = 1024 + 128 * vh; vcol = 2048 + 128 * vh; sscol = 0; }
    else { const int j = (vh - 8) >> 1, e = (vh - 8) & 1; qcol = 3072 + 128 * j; kcol = 3584 + 128 * j; gcol = 5120 + 128 * j; vcol = 4096 + 256 * j + 128 * e; sscol = 1 + j; }
    const int ocol = (vh < 8) ? qcol : vcol;
    float* stp = ST + (size_t)item * 16384;
    f32x4 S[8];
#pragma unroll
    for (int j = 0; j < 8; ++j)
#pragma unroll
        for (int i = 0; i < 4; ++i) S[j][i] = OUT ? stp[(16 * w + 4 * fq + i) * 128 + 16 * j + fr] : 0.f;
    float btot0 = 0.f, btot1 = 0.f;
#pragma unroll 1
    for (int c = 0; c < 8; ++c) {
        const bf16_t* rb = P + (size_t)(row0 + 64 * c) * LDP;
#pragma unroll
        for (int i = 0; i < 2; ++i) {
            const int p = tid + 512 * i, r = p >> 4, c8 = p & 15;
            const bf16_t* src = rb + (size_t)r * LDP + 8 * c8;
            const int lo = r * 256 + c8 * 16;
            *(LAS u32x4*)(lds + L_RAWG + lo) = *(const u32x4*)(src + gcol);
            *(LAS u32x4*)(lds + L_RAWV + lo) = *(const u32x4*)(src + vcol);
            if (kcol >= 0) *(LAS u32x4*)(lds + L_RAWK + lo) = *(const u32x4*)(src + kcol);
            if (OUT) *(LAS u32x4*)(lds + L_RAWQ + lo) = *(const u32x4*)(src + qcol);
        }
        __syncthreads();
        {
            float s0 = 0.f, s1 = 0.f;
#pragma unroll
            for (int j = 0; j < 8; ++j) { const unsigned gw = *(const LAS unsigned*)(lds + L_RAWG + (8 * w + j) * 256 + lane * 4); s0 += bf_lo(gw); s1 += bf_hi(gw); }
            *(LAS f32x2*)(lds + L_PSUM + (w * 128 + 2 * lane) * 4) = (f32x2){s0, s1};
        }
        __syncthreads();
        {
            float off0 = 0.f, off1 = 0.f, bref0 = 0.f, bref1 = 0.f, bl0 = 0.f, bl1 = 0.f;
#pragma unroll
            for (int ww = 0; ww < 8; ++ww) { const f32x2 p = *(const LAS f32x2*)(lds + L_PSUM + (ww * 128 + 2 * lane) * 4);
                if (ww < w) { off0 += p.x; off1 += p.y; } if (ww < 4) { bref0 += p.x; bref1 += p.y; } bl0 += p.x; bl1 += p.y; }
            float run0 = off0, run1 = off1;
            float ke0[8], ke1[8]; unsigned vv[8];
#pragma unroll
            for (int j = 0; j < 8; ++j) {
                const int t = 8 * w + j;
                const unsigned gw = *(const LAS unsigned*)(lds + L_RAWG + t * 256 + lane * 4);
                const float ga = bf_lo(gw), gb = bf_hi(gw);
                run0 += ga; run1 += gb;
                float kk0, kk1;
                if (kcol < 0) { kk0 = 1.f - __expf(ga); kk1 = 1.f - __expf(gb); }
                else { const unsigned kw = *(const LAS unsigned*)(lds + L_RAWK + t * 256 + lane * 4); kk0 = bf_lo(kw); kk1 = bf_hi(kw); }
                ke0[j] = kk0 * __expf(bl0 - run0); ke1[j] = kk1 * __expf(bl1 - run1);
                if (OUT) {
                    const unsigned qw = *(const LAS unsigned*)(lds + L_RAWQ + t * 256 + lane * 4);
                    *(LAS unsigned*)(lds + L_QM + t * 272 + lane * 4) = cvt_pk_bf16(bf_lo(qw) * __expf(run0 - bref0), bf_hi(qw) * __expf(run1 - bref1));
                    *(LAS unsigned*)(lds + L_KM + t * 272 + lane * 4) = cvt_pk_bf16(kk0 * __expf(bref0 - run0), kk1 * __expf(bref1 - run1));
                }
                vv[j] = *(const LAS unsigned*)(lds + L_RAWV + t * 256 + lane * 4);
            }
            u32x4 k0w, k1w, v0w, v1w;
            k0w.x = cvt_pk_bf16(ke0[0], ke0[1]); k0w.y = cvt_pk_bf16(ke0[2], ke0[3]); k0w.z = cvt_pk_bf16(ke0[4], ke0[5]); k0w.w = cvt_pk_bf16(ke0[6], ke0[7]);
            k1w.x = cvt_pk_bf16(ke1[0], ke1[1]); k1w.y = cvt_pk_bf16(ke1[2], ke1[3]); k1w.z = cvt_pk_bf16(ke1[4], ke1[5]); k1w.w = cvt_pk_bf16(ke1[6], ke1[7]);
            v0w.x = (vv[0] & 0xffffu) | (vv[1] << 16); v0w.y = (vv[2] & 0xffffu) | (vv[3] << 16); v0w.z = (vv[4] & 0xffffu) | (vv[5] << 16); v0w.w = (vv[6] & 0xffffu) | (vv[7] << 16);
            v1w.x = (vv[0] >> 16) | (vv[1] & 0xffff0000u); v1w.y = (vv[2] >> 16) | (vv[3] & 0xffff0000u); v1w.z = (vv[4] >> 16) | (vv[5] & 0xffff0000u); v1w.w = (vv[6] >> 16) | (vv[7] & 0xffff0000u);
            *(LAS u32x4*)(lds + L_KET + (2 * lane) * 144 + w * 16) = k0w; *(LAS u32x4*)(lds + L_KET + (2 * lane + 1) * 144 + w * 16) = k1w;
            *(LAS u32x4*)(lds + L_VT + (2 * lane) * 144 + w * 16) = v0w; *(LAS u32x4*)(lds + L_VT + (2 * lane + 1) * 144 + w * 16) = v1w;
            if (w == 0) { *(LAS f32x2*)(lds + L_EBREF + lane * 8) = (f32x2){__expf(bref0), __expf(bref1)}; *(LAS f32x2*)(lds + L_EBLAST + lane * 8) = (f32x2){__expf(bl0), __expf(bl1)}; }
            btot0 += bl0; btot1 += bl1;
        }
        __syncthreads();
        if (OUT) {
            {
                const f32x4 er = *(const LAS f32x4*)(lds + L_EBREF + (16 * w + 4 * fq) * 4);
#pragma unroll
                for (int j = 0; j < 8; ++j) { u32x2 o; o.x = cvt_pk_bf16(S[j][0] * er[0], S[j][1] * er[1]); o.y = cvt_pk_bf16(S[j][2] * er[2], S[j][3] * er[3]);
                    *(LAS u32x2*)(lds + L_ST + (16 * j + fr) * 272 + (16 * w + 4 * fq) * 2) = o; }
#pragma unroll
                for (int q = 0; q < 2; ++q) {
                    const int id = 2 * w + q, st = id >> 2, tt = id & 3;
                    f32x4 a = (f32x4){0.f, 0.f, 0.f, 0.f};
                    if (tt >= st) {
#pragma unroll
                        for (int kk = 0; kk < 4; ++kk) {
                            const bf16x8 xk = *(const LAS bf16x8*)(lds + L_KM + (16 * st + fr) * 272 + (32 * kk + 8 * fq) * 2);
                            const bf16x8 yq = *(const LAS bf16x8*)(lds + L_QM + (16 * tt + fr) * 272 + (32 * kk + 8 * fq) * 2);
                            a = __builtin_amdgcn_mfma_f32_16x16x32_bf16(xk, yq, a, 0, 0, 0);
                        }
                    }
                    const int t = 16 * tt + fr, s0 = 16 * st + 4 * fq;
                    u32x2 o; o.x = cvt_pk_bf16(s0 <= t ? a[0] : 0.f, s0 + 1 <= t ? a[1] : 0.f); o.y = cvt_pk_bf16(s0 + 2 <= t ? a[2] : 0.f, s0 + 3 <= t ? a[3] : 0.f);
                    *(LAS u32x2*)(lds + L_PB + t * 144 + s0 * 2) = o;
                }
            }
            __syncthreads();
#pragma unroll
            for (int tt = 0; tt < 4; ++tt) {
                f32x4 a = (f32x4){0.f, 0.f, 0.f, 0.f};
#pragma unroll
                for (int kk = 0; kk < 4; ++kk) {
                    const bf16x8 xs = *(const LAS bf16x8*)(lds + L_ST + (16 * w + fr) * 272 + (32 * kk + 8 * fq) * 2);
                    const bf16x8 yq = *(const LAS bf16x8*)(lds + L_QM + (16 * tt + fr) * 272 + (32 * kk + 8 * fq) * 2);
                    a = __builtin_amdgcn_mfma_f32_16x16x32_bf16(xs, yq, a, 0, 0, 0);
                }
#pragma unroll
                for (int ss = 0; ss < 2; ++ss) {
                    const bf16x8 xv = *(const LAS bf16x8*)(lds + L_VT + (16 * w + fr) * 144 + (32 * ss + 8 * fq) * 2);
                    const bf16x8 yp = *(const LAS bf16x8*)(lds + L_PB + (16 * tt + fr) * 144 + (32 * ss + 8 * fq) * 2);
                    a = __builtin_amdgcn_mfma_f32_16x16x32_bf16(xv, yp, a, 0, 0, 0);
                }
                float q2 = a[0] * a[0] + a[1] * a[1] + a[2] * a[2] + a[3] * a[3];
                q2 += __shfl_xor(q2, 16); q2 += __shfl_xor(q2, 32);
                if (fq == 0) *(LAS float*)(lds + L_RED + (w * 64 + 16 * tt + fr) * 4) = q2;
                u32x2 o; o.x = cvt_pk_bf16(a[0], a[1]); o.y = cvt_pk_bf16(a[2], a[3]);
                *(u32x2*)(P + (size_t)(row0 + 64 * c + 16 * tt + fr) * LDP + ocol + 16 * w + 4 * fq) = o;
            }
        }
        {
            const f32x4 el = *(const LAS f32x4*)(lds + L_EBLAST + (16 * w + 4 * fq) * 4);
            bf16x8 xk[2];
#pragma unroll
            for (int ss = 0; ss < 2; ++ss) xk[ss] = *(const LAS bf16x8*)(lds + L_KET + (16 * w + fr) * 144 + (32 * ss + 8 * fq) * 2);
#pragma unroll
            for (int j = 0; j < 8; ++j) {
                S[j] = S[j] * el;
#pragma unroll
                for (int ss = 0; ss < 2; ++ss) {
                    const bf16x8 yv = *(const LAS bf16x8*)(lds + L_VT + (16 * j + fr) * 144 + (32 * ss + 8 * fq) * 2);
                    S[j] = __builtin_amdgcn_mfma_f32_16x16x32_bf16(xk[ss], yv, S[j], 0, 0, 0);
                }
            }
        }
        __syncthreads();
        if (OUT) {
            if (tid < 64) { float tot = 0.f;
#pragma unroll
                for (int ww = 0; ww < 8; ++ww) tot += *(const LAS float*)(lds + L_RED + (ww * 64 + tid) * 4);
                atomicAdd(SS + (size_t)(row0 + 64 * c + tid) * 8 + sscol, tot); }
        }
    }
    if (!OUT) {
#pragma unroll
        for (int j = 0; j < 8; ++j)
#pragma unroll
            for (int i = 0; i < 4; ++i) stp[(16 * w + 4 * fq + i) * 128 + 16 * j + fr] = S[j][i];
        if (w == 0) *(f32x2*)(DSC + (size_t)item * 128 + 2 * lane) = (f32x2){__expf(btot0), __expf(btot1)};
    }
}


#define XB_TMO      128
#define XB_XCNT(j)  (256  + 64 * (j))
#define XB_XSUB(j)  (1280 + 64 * (j))
#define XB_XGEN(j)  (2304 + 64 * (j))
#define XB_TOP      3328
#define XB_TOPGEN   3392
#define XCD_BAR_WORDS 3456
#define XB_SPIN_CAP (1u << 18)
__device__ __forceinline__ unsigned xb_ld(unsigned* p)              { return __hip_atomic_load(p, __ATOMIC_RELAXED, __HIP_MEMORY_SCOPE_AGENT); }
__device__ __forceinline__ unsigned xb_add(unsigned* p, unsigned v) { return __hip_atomic_fetch_add(p, v, __ATOMIC_RELAXED, __HIP_MEMORY_SCOPE_AGENT); }
__device__ __forceinline__ unsigned xb_xcc_id() { return (unsigned)__builtin_amdgcn_s_getreg((3 << 11) | 20) & 0xFu; }
#define XB_SPIN(cond, bar) do { unsigned _sp = 0; while (cond) { __builtin_amdgcn_s_sleep(1); \
    if ((++_sp & 255u) == 0u) { if (xb_ld(&(bar)[XB_TMO])) break; if (_sp > XB_SPIN_CAP) { atomicAdd(&(bar)[XB_TMO], 1u); break; } } } } while (0)
struct XcdBarrier { unsigned* bar; unsigned x; volatile LAS unsigned* st; };
__device__ __forceinline__ XcdBarrier xcd_barrier_post(unsigned* bar, volatile LAS unsigned* st) {
    XcdBarrier b; b.bar = bar; b.x = xb_xcc_id(); b.st = st;
    if (threadIdx.x == 0) (void)xb_add(&bar[XB_XCNT(b.x)], 1u);
    return b;
}
__device__ __forceinline__ void xcd_barrier_complete(unsigned* bar, unsigned x, unsigned& nloc, unsigned& nx) {
    const unsigned G = gridDim.x * gridDim.y * gridDim.z;
    unsigned sum, cnt, mine, sp = 0u;
    for (;;) {
        sum = 0u; cnt = 0u; mine = 0u;
#pragma unroll
        for (unsigned j = 0; j < 16; ++j) { const unsigned c = xb_ld(&bar[XB_XCNT(j)]); sum += c; cnt += (c > 0u) ? 1u : 0u; mine = (j == x) ? c : mine; }
        if (sum == G) break;
        __builtin_amdgcn_s_sleep(1);
        if ((++sp & 255u) == 0u) { if (xb_ld(&bar[XB_TMO])) break; if (sp > XB_SPIN_CAP) { atomicAdd(&bar[XB_TMO], 1u); break; } }
    }
    nloc = mine > 0u ? mine : 1u; nx = cnt > 0u ? cnt : 1u;
}
__device__ __forceinline__ void xcd_barrier(const XcdBarrier& b) {
    asm volatile("s_waitcnt vmcnt(0)" ::: "memory");
    __syncthreads();
    if (threadIdx.x == 0) {
        unsigned* bar = b.bar;
        __builtin_amdgcn_s_waitcnt(0);
        unsigned nloc = b.st[0], nx = b.st[1];
        if (nloc == 0u) { xcd_barrier_complete(bar, b.x, nloc, nx); b.st[0] = nloc; b.st[1] = nx; }
        const unsigned old = xb_add(&bar[XB_XSUB(b.x)], 1u);
        const unsigned gen = old / nloc;
        if (old + 1u == (gen + 1u) * nloc) {
            __builtin_amdgcn_fence(__ATOMIC_RELEASE, "agent");
            asm volatile("s_waitcnt vmcnt(0)" ::: "memory");
            const unsigned og = xb_add(&bar[XB_TOP], 1u);
            const unsigned tg = og / nx;
            if (og + 1u == (tg + 1u) * nx) xb_add(&bar[XB_TOPGEN], 1u);
            else XB_SPIN(xb_ld(&bar[XB_TOPGEN]) == tg, bar);
            __builtin_amdgcn_fence(__ATOMIC_ACQUIRE, "agent");
            xb_add(&bar[XB_XGEN(b.x)], 1u);
            asm volatile("s_waitcnt vmcnt(0)" ::: "memory");
        } else {
            XB_SPIN(xb_ld(&bar[XB_XGEN(b.x)]) == gen, bar);
            __builtin_amdgcn_fence(__ATOMIC_ACQUIRE, "agent");
            asm volatile("s_waitcnt vmcnt(0)" ::: "memory");
        }
    }
    __syncthreads();
}

struct Args { const float* x; const float* c; const float* ada_w; const float* ada_b; const float* norm_w; const float* w_in; const float* lb_logits; const float* hnw;
              const float* alpha_w; const float* alpha_b; const float* gnw; const float* w_branch; const float* w_out; const float* fnw; float* out; unsigned char* ws; };

#ifndef PROBE_MASK
#define PROBE_MASK 0
#endif
#define PH_END(id) do { if ((id) == 0) { grid.sync(); xbar = xcd_barrier_post((unsigned*)(ws + WS_BAR), (volatile LAS unsigned*)(lds + L_BARST)); } else xcd_barrier(xbar); if (PROBE_MASK) { const unsigned long long now_ = __builtin_amdgcn_s_memrealtime(); if ((PROBE_MASK >> (id)) & 1) tacc += now_ - tprev; tprev = now_; } } while (0)
__global__ void __launch_bounds__(512, 2) fwd_megakernel(Args a) {
    extern __shared__ __attribute__((aligned(16))) unsigned char lds_raw[];
    LAS unsigned char* lds = (LAS unsigned char*)lds_raw;
    cg::grid_group grid = cg::this_grid();
    const int tid = threadIdx.x, lane = tid & 63, wave = __builtin_amdgcn_readfirstlane(tid >> 6);
    const int G = gridDim.x, bid = blockIdx.x;
    const int gw = bid * 8 + wave, NGW = G * 8;
    unsigned char* ws = a.ws;
    XcdBarrier xbar; xbar.bar = nullptr; xbar.x = 0; xbar.st = nullptr;
    if (tid < 2) *(volatile LAS unsigned*)(lds + L_BARST + 4 * tid) = 0u;
    if (bid == 0) for (int i = tid; i < XCD_BAR_WORDS; i += 512) __hip_atomic_store((unsigned*)(ws + WS_BAR) + i, 0u, __ATOMIC_RELAXED, __HIP_MEMORY_SCOPE_AGENT);
    unsigned long long tacc = 0ull, tprev = PROBE_MASK ? __builtin_amdgcn_s_memrealtime() : 0ull;
    float* mod = (float*)(ws + WS_MOD); float* lbv = (float*)(ws + WS_LB); float* SS = (float*)(ws + WS_SS); float* DSC = (float*)(ws + WS_DSC);
    bf16_t* D1 = (bf16_t*)(ws + WS_D1); bf16_t* P = (bf16_t*)(ws + WS_P);
    bf16_t* H = (bf16_t*)((unsigned char*)a.out + OUT_H); float* ST = (float*)((unsigned char*)a.out + OUT_ST);

    for (int jb = bid; jb < 192; jb += G) {
        LAS float* cact = (LAS float*)lds; LAS float* red = cact + 2048;
        for (int i = tid; i < 2048; i += 512) { const float v = a.c[i]; cact[i] = v * fsigmoid(v); }
        __syncthreads();
        const int l = jb / 96, j0 = (jb % 96) * 32, jj = tid & 31, seg = tid >> 5;
        const float* wp = a.ada_w + (size_t)l * 1024 * 3072 + j0 + jj;
        float a0 = 0.f, a1 = 0.f;
#pragma unroll 8
        for (int i = seg * 64; i < seg * 64 + 64; ++i) { const float wv = wp[(size_t)i * 3072]; a0 += cact[i] * wv; a1 += cact[1024 + i] * wv; }
        red[(seg * 32 + jj) * 2] = a0; red[(seg * 32 + jj) * 2 + 1] = a1;
        __syncthreads();
        if (tid < 64) { const int j2 = tid & 31, b = tid >> 5; float s = 0.f;
#pragma unroll
            for (int sg = 0; sg < 16; ++sg) s += red[(sg * 32 + j2) * 2 + b];
            mod[(l * 2 + b) * 3072 + j0 + j2] = s + a.ada_b[l * 3072 + j0 + j2]; }
        __syncthreads();
    }
    for (int j = bid * 512 + tid; j < 1024; j += G * 512) {
        const float l0 = a.lb_logits[j], l1 = a.lb_logits[1024 + j], mx = fmaxf(l0, l1), e0 = __expf(l0 - mx), e1 = __expf(l1 - mx);
        const float p0 = e0 / (e0 + e1), p1 = e1 / (e0 + e1);
        lbv[j] = 0.f; lbv[1024 + j] = fminf(fmaxf((p0 + p1) - p0, 0.f), 1.f);
    }
    {
        LAS float* scr = (LAS float*)(lds + wave * 8448);
        for (int it = gw; it < 2 * 6400; it += NGW) {
            const int l = it / 6400; int r = it % 6400;
            bf16_t* WT = (bf16_t*)(ws + WS_W + (size_t)l * W_LAYER);
            const float* win = a.w_in + (size_t)l * 1024 * DIN;
            if (r < 1536) { tr_item(win, DIN, 0, WT, 0, scr, r, 96, lane); continue; } r -= 1536;
            if (r < 1024) { tr_item(win, DIN, 4096, WT, 3072, scr, r, 64, lane); continue; } r -= 1024;
            if (r < 256) { tr_item_la(win, a.alpha_w + (size_t)l * 16 * 512, WT, 5120, scr, r, lane); continue; } r -= 256;
            if (r < 512) { tr_item(win, DIN, 3072, WT, 5632, scr, r, 32, lane); continue; } r -= 512;
            if (r < 512) { tr_item(win, DIN, 6144, WT, 6656, scr, r, 32, lane); continue; } r -= 512;
            if (r < 1024) { tr_item(win, DIN, 7184, WT, 7680, scr, r, 64, lane); continue; } r -= 1024;
            if (r < 512) { tr_item(a.w_branch + (size_t)l * 2 * 1048576, 1024, 0, WT, 9728, scr, r, 32, lane); continue; } r -= 512;
            if (r < 512) { tr_item(a.w_branch + (size_t)l * 2 * 1048576 + 1048576, 1024, 0, WT, 10752, scr, r, 32, lane); continue; } r -= 512;
            tr_item(a.w_out + (size_t)l * 1048576, 1024, 0, WT, 11776, scr, r, 32, lane);
        }
    }
    PH_END(0);

#pragma unroll 1
    for (int l = 0; l < 2; ++l) {
        const bf16_t* WT = (const bf16_t*)(ws + WS_W + (size_t)l * W_LAYER);
        const float* modl = mod + l * 2 * 3072;
        { const int tid = opaque_tid(), lane = tid & 63, wave = __builtin_amdgcn_readfirstlane(tid >> 6), gw = bid * 8 + wave;
        for (int i = bid * 512 + tid; i < MROWS * 8; i += G * 512) SS[i] = 0.f;
        for (int m = gw; m < MROWS; m += NGW) {
            const int b = m >> 13;
            const f32x4* xr = (const f32x4*)(a.x + (size_t)m * DM) + lane;
            f32x4 v[4]; float s = 0.f;
#pragma unroll
            for (int j = 0; j < 4; ++j) v[j] = xr[64 * j];
            if (l == 1) { const u32x2* dr = (const u32x2*)(D1 + (size_t)m * DM) + lane;
#pragma unroll
                for (int j = 0; j < 4; ++j) { const u32x2 d = dr[64 * j]; v[j][0] += bf_lo(d.x); v[j][1] += bf_hi(d.x); v[j][2] += bf_lo(d.y); v[j][3] += bf_hi(d.y); } }
#pragma unroll
            for (int j = 0; j < 4; ++j) s += (v[j][0] * v[j][0] + v[j][1] * v[j][1]) + (v[j][2] * v[j][2] + v[j][3] * v[j][3]);
            const float rstd = rsqrtf(wave_sum(s) * (1.f / 1024.f) + EPS);
            const float* mb = modl + b * 3072; const float* nw = a.norm_w + l * 1024;
            u32x2* hr = (u32x2*)(H + (size_t)m * DM) + lane;
#pragma unroll
            for (int j = 0; j < 4; ++j) { const int col = 4 * lane + 256 * j;
                const f32x4 nv = *(const f32x4*)(nw + col), sh = *(const f32x4*)(mb + col), sc = *(const f32x4*)(mb + 1024 + col);
                const f32x4 h = v[j] * rstd * nv * (sc + 1.f) + sh;
                u32x2 o; o.x = cvt_pk_bf16(h[0], h[1]); o.y = cvt_pk_bf16(h[2], h[3]); hr[64 * j] = o; }
        } }
        PH_END(1);
        { pg8::Gemm g{H, WT, 1024, 1024}; pg8::StaticOrder S; S.init(MROWS, 5632, G, bid);
          EpiA1 E{P, lbv + l * 1024, a.alpha_b + l * 512};
          pg8::gemm_phase<EpiA1, pg8::StaticOrder>(lds, g, S, E); }
        PH_END(2);
        for (int item = bid; item < 512; item += G) la_item<false>(lds, P, ST, DSC, SS, item);
        PH_END(3);
        for (int gt = bid * 512 + opaque_tid(); gt < 32 * 4096; gt += G * 512) {
            const int chain = gt >> 12, e = gt & 4095, k = e >> 5;
            f32x4* p0 = (f32x4*)(ST + (size_t)chain * 16 * 16384) + e; const float* d0 = DSC + (size_t)chain * 16 * 128 + k;
            f32x4 cur[15]; float dd[15];
#pragma unroll
            for (int sc = 0; sc < 15; ++sc) { cur[sc] = p0[(size_t)sc * 4096]; dd[sc] = d0[sc * 128]; }
            f32x4 carry = (f32x4){0.f, 0.f, 0.f, 0.f};
#pragma unroll
            for (int sc = 0; sc < 16; ++sc) { p0[(size_t)sc * 4096] = carry; if (sc < 15) carry = carry * dd[sc] + cur[sc]; }
        }
        PH_END(4);
        for (int item = bid; item < 512; item += G) la_item<true>(lds, P, ST, DSC, SS, item);
        PH_END(5);
        { pg8::Gemm g{H, WT + (size_t)5632 * 1024, 1024, 1024}; pg8::StaticOrder S; S.init(MROWS, 4096, G, bid);
          EpiA2 E{P, SS, a.hnw + l * 1024, a.gnw + l * 256};
          pg8::gemm_phase<EpiA2, pg8::StaticOrder>(lds, g, S, E); }
        PH_END(6);
        { pg8::Gemm g{P, WT + (size_t)9728 * 1024, LDP, 1024}; pg8::BranchOrder S; S.s.init(MROWS, 1024, G, bid);
          EpiC1 E{P};
          pg8::gemm_phase<EpiC1, pg8::BranchOrder>(lds, g, S, E); }
        PH_END(7);
        { pg8::Gemm g{P + 3072, WT + (size_t)11776 * 1024, LDP, 1024}; pg8::StaticOrder S; S.init(MROWS, 1024, G, bid);
          if (l == 0) { EpiC2a E{D1, modl}; pg8::gemm_phase<EpiC2a, pg8::StaticOrder>(lds, g, S, E); }
          else { EpiC2b E{a.x, D1, a.out, modl}; pg8::gemm_phase<EpiC2b, pg8::StaticOrder>(lds, g, S, E); } }
        PH_END(8);
    }
    for (int m = gw; m < MROWS; m += NGW) {
        f32x4* xr = (f32x4*)(a.out + (size_t)m * DM) + lane;
        f32x4 v[4]; float s = 0.f;
#pragma unroll
        for (int j = 0; j < 4; ++j) { v[j] = xr[64 * j]; s += (v[j][0] * v[j][0] + v[j][1] * v[j][1]) + (v[j][2] * v[j][2] + v[j][3] * v[j][3]); }
        const float rstd = rsqrtf(wave_sum(s) * (1.f / 1024.f) + EPS);
#pragma unroll
        for (int j = 0; j < 4; ++j) { const f32x4 nv = *(const f32x4*)(a.fnw + 4 * lane + 256 * j); xr[64 * j] = v[j] * rstd * nv; }
    }
    if (PROBE_MASK) { if ((PROBE_MASK >> 9) & 1) tacc += __builtin_amdgcn_s_memrealtime() - tprev;
        if (bid == 0 && threadIdx.x == 0) { const unsigned long long t0 = __builtin_amdgcn_s_memrealtime(); while (__builtin_amdgcn_s_memrealtime() - t0 < 4ull * tacc) __builtin_amdgcn_s_sleep(32); } }
}

extern "C" void kernel_launch(void* const* d_in, const int* in_sizes, int n_in, void* d_out, int out_size, void* d_ws, size_t ws_size, hipStream_t stream) {
    static int grid = 0;
    if (grid == 0) {
        if (n_in != 14 || out_size != MROWS * DM || ws_size < WS_END) { fprintf(stderr, "kernel_launch: unexpected problem (n_in %d, out %d, ws %zu < %zu)\n", n_in, out_size, ws_size, (size_t)WS_END); grid = -1; return; }
        int dev = 0, cus = 0, per_cu = 0;
        if (hipGetDevice(&dev) != hipSuccess || hipDeviceGetAttribute(&cus, hipDeviceAttributeMultiprocessorCount, dev) != hipSuccess) { grid = -1; return; }
        if (hipFuncSetAttribute((const void*)fwd_megakernel, hipFuncAttributeMaxDynamicSharedMemorySize, LDS_BYTES) != hipSuccess) { fprintf(stderr, "kernel_launch: hipFuncSetAttribute failed\n"); grid = -1; return; }
        if (hipOccupancyMaxActiveBlocksPerMultiprocessor(&per_cu, (const void*)fwd_megakernel, 512, LDS_BYTES) != hipSuccess || per_cu < 1) { fprintf(stderr, "kernel_launch: occupancy query says %d\n", per_cu); grid = -1; return; }
        grid = cus;
    }
    if (grid < 0) return;
    Args a{};
    a.x = (const float*)d_in[0]; a.c = (const float*)d_in[1]; a.ada_w = (const float*)d_in[2]; a.ada_b = (const float*)d_in[3]; a.norm_w = (const float*)d_in[4]; a.w_in = (const float*)d_in[5];
    a.lb_logits = (const float*)d_in[6]; a.hnw = (const float*)d_in[7]; a.alpha_w = (const float*)d_in[8]; a.alpha_b = (const float*)d_in[9]; a.gnw = (const float*)d_in[10];
    a.w_branch = (const float*)d_in[11]; a.w_out = (const float*)d_in[12]; a.fnw = (const float*)d_in[13]; a.out = (float*)d_out; a.ws = (unsigned char*)d_ws;
    void* args[] = {&a};
    const hipError_t e = hipLaunchCooperativeKernel((const void*)fwd_megakernel, dim3(grid), dim3(512), args, LDS_BYTES, stream);
    if (e != hipSuccess) fprintf(stderr, "kernel_launch: cooperative launch failed: %s (grid %d)\n", hipGetErrorString(e), grid);
}
```

```cpp
#include <hip/hip_runtime.h>
#include <hip/hip_cooperative_groups.h>
#include <cstdio>
#include <cstdint>
namespace cg = cooperative_groups;

#define LAS __attribute__((address_space(3)))
typedef unsigned short bf16_t;
typedef short bf16x8 __attribute__((ext_vector_type(8)));
typedef float f32x4 __attribute__((ext_vector_type(4)));
typedef float f32x2 __attribute__((ext_vector_type(2)));
typedef unsigned u32x4 __attribute__((ext_vector_type(4)));
typedef unsigned u32x2 __attribute__((ext_vector_type(2)));

constexpr int MROWS = 16384, DM = 1024, SEQ = 8192, LDP = 5632, DIN = 9232;
constexpr float EPS = 1e-6f;
constexpr size_t WS_MOD = 4096, WS_LB = 53248, WS_SS = 65536, WS_DSC = 589824, WS_BAR = 860160, WS_W = 1048576, W_LAYER = 26214400;
constexpr size_t WS_D1 = WS_W + 2 * W_LAYER, WS_P = WS_D1 + (size_t)MROWS * DM * 2, WS_END = WS_P + (size_t)MROWS * LDP * 2;
constexpr size_t OUT_H = 0, OUT_ST = 33554432;
constexpr int LDS_BYTES = 147456, L_BARST = 146432;

__device__ __forceinline__ unsigned cvt_pk_bf16(float lo, float hi) { unsigned r; asm volatile("v_cvt_pk_bf16_f32 %0, %1, %2" : "=v"(r) : "v"(lo), "v"(hi)); return r; }
__device__ __forceinline__ float bf_lo(unsigned w) { return __uint_as_float(w << 16); }
__device__ __forceinline__ float bf_hi(unsigned w) { return __uint_as_float(w & 0xffff0000u); }
__device__ __forceinline__ float fsigmoid(float v) { return __builtin_amdgcn_rcpf(1.f + __expf(-v)); }
__device__ __forceinline__ int opaque_tid() { int t = threadIdx.x; asm volatile("" : "+v"(t)); return t; }
__device__ __forceinline__ float wave_sum(float v) {
#pragma unroll
    for (int o = 1; o < 64; o <<= 1) v += __shfl_xor(v, o);
    return v;
}

namespace pg8 {
constexpr int BM = 256, BK = 64, HALF = 128, HTB = HALF * BK * 2, STAGE_BYTES = 8 * HTB, NXCD = 8, WGM = 8;
__host__ __device__ __forceinline__ int lds_byte(int r, int c) { const int st = (r >> 4) * 2 + (c >> 5), rr = r & 15, cc = c & 31, ob = rr * 64 + cc * 2; return st * 1024 + (ob ^ (((ob >> 9) & 1) << 5)); }
__host__ __device__ __forceinline__ void stage_rc(int b, int& R, int& C) { const int st = b / 1024, sb = b % 1024, swz = sb ^ (((sb >> 9) & 1) << 5); R = (st >> 1) * 16 + swz / 64; C = (st & 1) * 32 + (swz % 64) / 2; }
__host__ __device__ __forceinline__ int perm32(int rho) { const int n = rho >> 4, i = rho & 15; return 8 * (i >> 2) + 4 * n + (i & 3); }

struct Unit { int pm, pn, br; unsigned ao, bo; };
struct Gemm { const bf16_t* A; const bf16_t* Bt; int lda, K; };

struct StaticOrder {
    int nM, nN, nwg, G, c;
    __host__ __device__ void init(int M, int N, int G_, int c_) { nM = M / BM; nN = N / BM; nwg = nM * nN; G = G_; c = c_; }
    __host__ __device__ bool next(int i, Unit& u) const {
        const long L = (long)i * G + c; if (L >= nwg) return false;
        int wgid = (int)L; { const int q = nwg / NXCD, r = nwg % NXCD, xcd = wgid % NXCD, off = wgid / NXCD; wgid = (xcd < r ? xcd * (q + 1) : r * (q + 1) + (xcd - r) * q) + off; }
        const int nig = WGM * nN, gid = wgid / nig, fm = gid * WGM, gsz = (nM - fm) < WGM ? (nM - fm) : WGM;
        u.pm = fm + ((wgid % nig) % gsz); u.pn = (wgid % nig) / gsz; u.br = 0; u.ao = 0u; u.bo = 0u; return true;
    }
};
struct BranchOrder {
    StaticOrder s;
    __host__ __device__ bool next(int i, Unit& u) const { if (!s.next(i >> 1, u)) return false; u.br = i & 1; u.ao = (i & 1) ? 4096u * 2u : 0u; u.bo = (i & 1) ? 1024u * 1024u * 2u : 0u; return true; }
};

template <class Epi, class Sched>
__device__ __forceinline__ void gemm_phase(LAS unsigned char* lds, const Gemm g, const Sched& S, const Epi& E) {
    const int tid = opaque_tid(), wid = __builtin_amdgcn_readfirstlane(tid >> 6), lane = tid & 63, wr = wid >> 2, wc = wid & 3, fr = lane & 15, fq = lane >> 4;
    const int K = g.K, nt = K / BK, lda = g.lda;
    unsigned voffA[2], voffB[2];
#pragma unroll
    for (int i = 0; i < 2; ++i) { int R, C; stage_rc(tid * 16 + i * 8192, R, C); const int Rb = Epi::PERM ? ((R & ~31) + perm32(R & 31)) : R;
        voffA[i] = (unsigned)(R * lda + C) * 2u; voffB[i] = (unsigned)(Rb * K + C) * 2u;
        asm volatile("" : "+v"(voffA[i]), "+v"(voffB[i])); }
    const size_t kstep = (size_t)(BK * 2);
    const size_t hA = (size_t)HALF * lda * 2, tA = 2 * hA, hB = (size_t)HALF * K * 2, tB = 2 * hB;
    const unsigned ldsw = (unsigned)wid * 1024u;
    const int aoff = lds_byte(wr * 64 + fr, fq * 8), boff = lds_byte(wc * 32 + fr, fq * 8);
#define PG8_SA(b, h) (((b) * 2 + (h)) * HTB)
#define PG8_SB(b, h) ((4 + (b) * 2 + (h)) * HTB)
#define PG8_STAGE(bufoff, gbase, voff) do { _Pragma("unroll") for (int _i = 0; _i < 2; ++_i) \
        __builtin_amdgcn_global_load_lds((const unsigned*)((const char*)(gbase) + (voff)[_i]), (LAS unsigned*)(lds + (bufoff) + ldsw + _i * 8192), 16, 0, 0); } while (0)
#define PG8_LDA(dst, b, h) do { _Pragma("unroll") for (int m = 0; m < 4; ++m) _Pragma("unroll") for (int k = 0; k < 2; ++k) dst[m][k] = *(const LAS bf16x8*)(lds + PG8_SA(b, h) + aoff + m * 2048 + k * 1024); } while (0)
#define PG8_LDB(dst, b, h) do { _Pragma("unroll") for (int n = 0; n < 2; ++n) _Pragma("unroll") for (int k = 0; k < 2; ++k) dst[n][k] = *(const LAS bf16x8*)(lds + PG8_SB(b, h) + boff + n * 2048 + k * 1024); } while (0)
#define PG8_MMA(ai, bj, At, Bt) do { __builtin_amdgcn_s_setprio(1); _Pragma("unroll") for (int m = 0; m < 4; ++m) _Pragma("unroll") for (int n = 0; n < 2; ++n) _Pragma("unroll") for (int k = 0; k < 2; ++k) \
        acc[ai][bj][m][n] = __builtin_amdgcn_mfma_f32_16x16x32_bf16(Bt[n][k], At[m][k], acc[ai][bj][m][n], 0, 0, 0); __builtin_amdgcn_s_setprio(0); } while (0)
#define PG8_WAIT_V(n) asm volatile("s_waitcnt vmcnt(" #n ")" ::: "memory")
#define PG8_WAIT_L(n) asm volatile("s_waitcnt lgkmcnt(" #n ")" ::: "memory")
#define PG8_BAR __builtin_amdgcn_s_barrier()
#define PG8_SCHED __builtin_amdgcn_sched_barrier(0)
    Unit cur, nxt; int ui = 0;
    if (!S.next(0, cur)) return;
    f32x4 acc[2][2][4][2];
#pragma unroll
    for (int a = 0; a < 2; ++a)
#pragma unroll
        for (int b = 0; b < 2; ++b)
#pragma unroll
            for (int m = 0; m < 4; ++m)
#pragma unroll
                for (int n = 0; n < 2; ++n) acc[a][b][m][n] = (f32x4){0.f, 0.f, 0.f, 0.f};
    bf16x8 At[4][2], B0[2][2], B1[2][2];
    const char* cA = (const char*)g.A + (size_t)cur.pm * tA + cur.ao; const char* cB = (const char*)g.Bt + (size_t)cur.pn * tB + cur.bo;
    PG8_STAGE(PG8_SB(0, 0), cB, voffB); PG8_STAGE(PG8_SB(0, 1), cB + hB, voffB); PG8_STAGE(PG8_SA(0, 0), cA, voffA); PG8_STAGE(PG8_SA(0, 1), cA + hA, voffA);
    if (wr == 1) PG8_BAR;
    PG8_WAIT_V(2); PG8_BAR;
    PG8_STAGE(PG8_SB(1, 0), cB + kstep, voffB); PG8_STAGE(PG8_SA(1, 0), cA + kstep, voffA); PG8_STAGE(PG8_SB(1, 1), cB + hB + kstep, voffB);
    PG8_WAIT_V(6); PG8_BAR;
    for (;;) {
        const bool has_next = S.next(ui + 1, nxt);
        const char* nA = has_next ? (const char*)g.A + (size_t)nxt.pm * tA + nxt.ao : cA; const char* nB = has_next ? (const char*)g.Bt + (size_t)nxt.pn * tB + nxt.bo : cB;
        for (int t = 0; t < nt; t += 2) {
            const bool last = (t == nt - 2);
            const char* a1 = cA + (size_t)(t + 1) * kstep;
            const char* a2 = last ? nA : cA + (size_t)(t + 2) * kstep; const char* b2 = last ? nB : cB + (size_t)(t + 2) * kstep;
            const char* a3 = a2 + kstep; const char* b3 = b2 + kstep;
            PG8_LDB(B0, 0, 0); PG8_LDB(B1, 0, 1); PG8_SCHED; PG8_LDA(At, 0, 0); PG8_STAGE(PG8_SA(1, 1), a1 + hA, voffA);
            PG8_WAIT_V(8); PG8_WAIT_L(0); PG8_BAR; PG8_MMA(0, 0, At, B0); PG8_MMA(0, 1, At, B1); PG8_BAR; PG8_SCHED;
            PG8_LDA(At, 0, 1); PG8_STAGE(PG8_SB(0, 0), b2, voffB); PG8_STAGE(PG8_SB(0, 1), b2 + hB, voffB); PG8_STAGE(PG8_SA(0, 0), a2, voffA);
            PG8_WAIT_V(8); PG8_WAIT_L(0); PG8_BAR; PG8_MMA(1, 0, At, B0); PG8_MMA(1, 1, At, B1); PG8_BAR; PG8_SCHED;
            PG8_LDB(B0, 1, 0); PG8_LDB(B1, 1, 1); PG8_SCHED; PG8_LDA(At, 1, 0); PG8_STAGE(PG8_SA(0, 1), a2 + hA, voffA);
            PG8_WAIT_V(8); PG8_WAIT_L(0); PG8_BAR; PG8_MMA(0, 0, At, B0); PG8_MMA(0, 1, At, B1); PG8_BAR; PG8_SCHED;
            PG8_LDA(At, 1, 1); PG8_STAGE(PG8_SB(1, 0), b3, voffB); PG8_STAGE(PG8_SB(1, 1), b3 + hB, voffB); PG8_STAGE(PG8_SA(1, 0), a3, voffA);
            PG8_WAIT_V(8); PG8_WAIT_L(0); PG8_BAR; PG8_MMA(1, 0, At, B0); PG8_MMA(1, 1, At, B1); PG8_BAR; PG8_SCHED;
        }
        if (wr == 0) PG8_BAR;
        E(acc, cur, wr, wc, fr, fq);
        if (!has_next) break;
#pragma unroll
        for (int a = 0; a < 2; ++a)
#pragma unroll
            for (int b = 0; b < 2; ++b)
#pragma unroll
                for (int m = 0; m < 4; ++m)
#pragma unroll
                    for (int n = 0; n < 2; ++n) acc[a][b][m][n] = (f32x4){0.f, 0.f, 0.f, 0.f};
        cur = nxt; cA = nA; cB = nB; ++ui;
        if (wr == 1) PG8_BAR;
    }
    PG8_WAIT_V(0);
    PG8_BAR;
#undef PG8_SA
#undef PG8_SB
#undef PG8_STAGE
#undef PG8_LDA
#undef PG8_LDB
#undef PG8_MMA
#undef PG8_WAIT_V
#undef PG8_WAIT_L
#undef PG8_BAR
#undef PG8_SCHED
}
}
using pg8::Unit;

__device__ __forceinline__ void unpack8(const u32x4 w, float (&o)[8]) { o[0] = bf_lo(w.x); o[1] = bf_hi(w.x); o[2] = bf_lo(w.y); o[3] = bf_hi(w.y); o[4] = bf_lo(w.z); o[5] = bf_hi(w.z); o[6] = bf_lo(w.w); o[7] = bf_hi(w.w); }
__device__ __forceinline__ u32x4 pack8(const float (&v)[8]) { u32x4 w; w.x = cvt_pk_bf16(v[0], v[1]); w.y = cvt_pk_bf16(v[2], v[3]); w.z = cvt_pk_bf16(v[4], v[5]); w.w = cvt_pk_bf16(v[6], v[7]); return w; }

struct EpiA1 {
    static constexpr bool PERM = true;
    bf16_t* P; const float* lb; const float* ab;
    __device__ __forceinline__ void operator()(const f32x4 (&acc)[2][2][4][2], const Unit& u, int wr, int wc, int fr, int fq) const {
        const int pn = u.pn;
        const int type = pn < 4 ? 0 : pn < 8 ? 1 : pn < 12 ? 2 : pn < 14 ? 3 : pn < 20 ? 2 : 4;
        const int row0 = u.pm * 256 + wr * 64 + fr, colb = pn * 256 + wc * 32 + 8 * fq;
#pragma unroll
        for (int bj = 0; bj < 2; ++bj) {
            const int col = colb + bj * 128;
            float pr[8];
#pragma unroll
            for (int e = 0; e < 8; ++e) pr[e] = 0.f;
            if (type == 1) { const f32x4 p0 = *(const f32x4*)(lb + col - 1024), p1 = *(const f32x4*)(lb + col - 1024 + 4); pr[0] = p0[0]; pr[1] = p0[1]; pr[2] = p0[2]; pr[3] = p0[3]; pr[4] = p1[0]; pr[5] = p1[1]; pr[6] = p1[2]; pr[7] = p1[3]; }
            if (type == 4) { const f32x4 p0 = *(const f32x4*)(ab + col - 5120), p1 = *(const f32x4*)(ab + col - 5120 + 4); pr[0] = p0[0]; pr[1] = p0[1]; pr[2] = p0[2]; pr[3] = p0[3]; pr[4] = p1[0]; pr[5] = p1[1]; pr[6] = p1[2]; pr[7] = p1[3]; }
#pragma unroll
            for (int ai = 0; ai < 2; ++ai)
#pragma unroll
                for (int m = 0; m < 4; ++m) {
                    const int row = row0 + ai * 128 + m * 16;
                    float v[8];
#pragma unroll
                    for (int e = 0; e < 4; ++e) { v[e] = acc[ai][bj][m][0][e]; v[4 + e] = acc[ai][bj][m][1][e]; }
                    if (type == 0) {
#pragma unroll
                        for (int e = 0; e < 8; ++e) v[e] = v[e] * fsigmoid(v[e]);
                    } else if (type == 1) {
#pragma unroll
                        for (int e = 0; e < 8; ++e) { const float f = pr[e] + (1.f - pr[e]) * fsigmoid(v[e]); v[e] = __logf(fmaxf(f, 1e-20f)); }
                    } else if (type == 3) {
#pragma unroll
                        for (int e = 0; e < 8; ++e) v[e] *= 0.08838834764831845f;
                    } else if (type == 4) {
#pragma unroll
                        for (int e = 0; e < 8; ++e) { const float z = v[e] + pr[e]; v[e] = (fminf(z, 0.f) - __logf(1.f + __expf(-fabsf(z)))) * 0.0625f; }
                    }
                    *(u32x4*)(P + (size_t)row * LDP + col) = pack8(v);
                }
        }
    }
};
struct EpiA2 {
    static constexpr bool PERM = true;
    bf16_t* P; const float* SS; const float* hnw; const float* gnw;
    __device__ __forceinline__ void operator()(const f32x4 (&acc)[2][2][4][2], const Unit& u, int wr, int wc, int fr, int fq) const {
        const int pn = u.pn;
        const int row0 = u.pm * 256 + wr * 64 + fr, cw = wc * 32 + 8 * fq;
#pragma unroll
        for (int bj = 0; bj < 2; ++bj) {
            const int cin = cw + bj * 128;
            float nw[8];
#pragma unroll
            for (int e = 0; e < 8; ++e) nw[e] = 1.f;
            int dcol;
            if (pn < 4) { dcol = pn * 256 + cin; const f32x4 p0 = *(const f32x4*)(hnw + dcol), p1 = *(const f32x4*)(hnw + dcol + 4); nw[0] = p0[0]; nw[1] = p0[1]; nw[2] = p0[2]; nw[3] = p0[3]; nw[4] = p1[0]; nw[5] = p1[1]; nw[6] = p1[2]; nw[7] = p1[3]; }
            else if (pn < 8) { dcol = 4096 + (pn - 4) * 256 + cin; const f32x4 p0 = *(const f32x4*)(gnw + cin), p1 = *(const f32x4*)(gnw + cin + 4); nw[0] = p0[0]; nw[1] = p0[1]; nw[2] = p0[2]; nw[3] = p0[3]; nw[4] = p1[0]; nw[5] = p1[1]; nw[6] = p1[2]; nw[7] = p1[3]; }
            else dcol = 1024 + (pn - 8) * 256 + cin;
#pragma unroll
            for (int ai = 0; ai < 2; ++ai)
#pragma unroll
                for (int m = 0; m < 4; ++m) {
                    const int row = row0 + ai * 128 + m * 16;
                    float v[8];
#pragma unroll
                    for (int e = 0; e < 4; ++e) { v[e] = acc[ai][bj][m][0][e]; v[4 + e] = acc[ai][bj][m][1][e]; }
                    bf16_t* dst = P + (size_t)row * LDP + dcol;
                    if (pn < 8) {
                        const float ssv = (pn < 4) ? SS[row * 8] : SS[row * 8 + 1 + (pn - 4)];
                        const float rstd = rsqrtf(ssv * ((pn < 4) ? (1.f / 1024.f) : (1.f / 256.f)) + EPS);
                        float o[8]; unpack8(*(const u32x4*)dst, o);
#pragma unroll
                        for (int e = 0; e < 8; ++e) v[e] = o[e] * rstd * nw[e] * (v[e] * fsigmoid(v[e]));
                    } else {
#pragma unroll
                        for (int e = 0; e < 8; ++e) v[e] = fsigmoid(v[e]);
                    }
                    *(u32x4*)dst = pack8(v);
                }
        }
    }
};
struct EpiC1 {
    static constexpr bool PERM = true;
    bf16_t* P;
    __device__ __forceinline__ void operator()(const f32x4 (&acc)[2][2][4][2], const Unit& u, int wr, int wc, int fr, int fq) const {
        const int br = u.br;
        const int row0 = u.pm * 256 + wr * 64 + fr, colb = u.pn * 256 + wc * 32 + 8 * fq;
#pragma unroll
        for (int bj = 0; bj < 2; ++bj) {
            const int c = colb + bj * 128;
#pragma unroll
            for (int ai = 0; ai < 2; ++ai)
#pragma unroll
                for (int m = 0; m < 4; ++m) {
                    const int row = row0 + ai * 128 + m * 16;
                    float v[8], gt[8];
#pragma unroll
                    for (int e = 0; e < 4; ++e) { v[e] = acc[ai][bj][m][0][e]; v[4 + e] = acc[ai][bj][m][1][e]; }
                    bf16_t* rp = P + (size_t)row * LDP;
                    unpack8(*(const u32x4*)(rp + 1024 + 1024 * br + c), gt);
#pragma unroll
                    for (int e = 0; e < 8; ++e) v[e] *= gt[e];
                    if (br) { float o[8]; unpack8(*(const u32x4*)(rp + 3072 + c), o);
#pragma unroll
                        for (int e = 0; e < 8; ++e) v[e] += o[e]; }
                    *(u32x4*)(rp + 3072 + c) = pack8(v);
                }
        }
    }
};
struct EpiC2a {
    static constexpr bool PERM = true;
    bf16_t* D1; const float* mod;
    __device__ __forceinline__ void operator()(const f32x4 (&acc)[2][2][4][2], const Unit& u, int wr, int wc, int fr, int fq) const {
        const int row0 = u.pm * 256 + wr * 64 + fr, colb = u.pn * 256 + wc * 32 + 8 * fq;
        const float* gp = mod + (u.pm >> 5) * 3072 + 2048;
#pragma unroll
        for (int bj = 0; bj < 2; ++bj) {
            const int c = colb + bj * 128;
            const f32x4 g0 = *(const f32x4*)(gp + c), g1 = *(const f32x4*)(gp + c + 4);
#pragma unroll
            for (int ai = 0; ai < 2; ++ai)
#pragma unroll
                for (int m = 0; m < 4; ++m) {
                    const int row = row0 + ai * 128 + m * 16;
                    float v[8];
#pragma unroll
                    for (int e = 0; e < 4; ++e) { v[e] = acc[ai][bj][m][0][e] * g0[e]; v[4 + e] = acc[ai][bj][m][1][e] * g1[e]; }
                    *(u32x4*)(D1 + (size_t)row * DM + c) = pack8(v);
                }
        }
    }
};
struct EpiC2b {
    static constexpr bool PERM = false;
    const float* x; const bf16_t* D1; float* out; const float* mod;
    __device__ __forceinline__ void operator()(const f32x4 (&acc)[2][2][4][2], const Unit& u, int wr, int wc, int fr, int fq) const {
        const int row0 = u.pm * 256 + wr * 64 + fr, colb = u.pn * 256 + wc * 32 + 4 * fq;
        const float* gp = mod + (u.pm >> 5) * 3072 + 2048;
#pragma unroll
        for (int bj = 0; bj < 2; ++bj)
#pragma unroll
            for (int n = 0; n < 2; ++n) {
                const int c = colb + bj * 128 + n * 16;
                const f32x4 gv = *(const f32x4*)(gp + c);
#pragma unroll
                for (int ai = 0; ai < 2; ++ai)
#pragma unroll
                    for (int m = 0; m < 4; ++m) {
                        const size_t off = (size_t)(row0 + ai * 128 + m * 16) * DM + c;
                        const f32x4 xv = *(const f32x4*)(x + off); const u32x2 d = *(const u32x2*)(D1 + off);
                        f32x4 o = xv + acc[ai][bj][m][n] * gv; o[0] += bf_lo(d.x); o[1] += bf_hi(d.x); o[2] += bf_lo(d.y); o[3] += bf_hi(d.y);
                        *(f32x4*)(out + off) = o;
                    }
            }
    }
};

__device__ __forceinline__ unsigned f2bf(float f) { unsigned u = __float_as_uint(f); return (u + 0x7fffu + ((u >> 16) & 1u)) >> 16; }
__device__ __forceinline__ unsigned pk2(float lo, float hi) { return f2bf(lo) | (f2bf(hi) << 16); }
__device__ __forceinline__ void tr_write(bf16_t* WT, int row_off, int n0, int k0, LAS float* scr, int lane) {
    asm volatile("s_waitcnt lgkmcnt(0)" ::: "memory");
    const int c = lane & 7;
#pragma unroll
    for (int j = 0; j < 4; ++j) { const int n = (lane >> 3) + 8 * j; const LAS float* s = scr + (8 * c) * 33 + n;
        u32x4 o; o.x = pk2(s[0 * 33], s[1 * 33]); o.y = pk2(s[2 * 33], s[3 * 33]); o.z = pk2(s[4 * 33], s[5 * 33]); o.w = pk2(s[6 * 33], s[7 * 33]);
        *(u32x4*)(WT + (size_t)(row_off + n0 + n) * 1024 + k0 + 8 * c) = o; }
    asm volatile("s_waitcnt lgkmcnt(0)" ::: "memory");
}
__device__ __forceinline__ void tr_item(const float* W, int ldw, int col0, bf16_t* WT, int row_off, LAS float* scr, int item, int nblk, int lane) {
    const int kb = item / nblk, nb = item % nblk, k0 = 64 * kb, n0 = 32 * nb;
#pragma unroll 8
    for (int i = 0; i < 32; ++i) { const int kk = 2 * i + (lane >> 5); scr[kk * 33 + (lane & 31)] = W[(size_t)(k0 + kk) * ldw + col0 + n0 + (lane & 31)]; }
    tr_write(WT, row_off, n0, k0, scr, lane);
}
__device__ __forceinline__ void tr_item_la(const float* win, const float* aw, bf16_t* WT, int row_off, LAS float* scr, int item, int lane) {
    const int kb = item / 16, nb = item % 16, k0 = 64 * kb, n0 = 32 * nb;
    float awr[16];
#pragma unroll
    for (int r = 0; r < 16; ++r) awr[r] = aw[r * 512 + n0 + (lane & 31)];
#pragma unroll 4
    for (int i = 0; i < 32; ++i) { const int kk = 2 * i + (lane >> 5); const float* wr_ = win + (size_t)(k0 + kk) * DIN + 7168; float s = 0.f;
#pragma unroll
        for (int r = 0; r < 16; ++r) s += wr_[r] * awr[r];
        scr[kk * 33 + (lane & 31)] = s; }
    tr_write(WT, row_off, n0, k0, scr, lane);
}

constexpr int L_RAWQ = 0, L_RAWK = 16384, L_RAWG = 32768, L_RAWV = 49152;
constexpr int L_ST = 0, L_PB = 36864;
constexpr int L_QM = 65536, L_KM = 82944, L_KET = 100352, L_VT = 118784;
constexpr int L_PSUM = 137216, L_EBREF = 141312, L_EBLAST = 141824, L_RED = 142336;
static_assert(L_RED + 2048 <= LDS_BYTES, "LDS map");

template <bool OUT>
__device__ __forceinline__ void la_item(LAS unsigned char* lds, bf16_t* P, float* ST, float* DSC, float* SS, int item) {
    const int tid = opaque_tid();
    const int lane = tid & 63, w = __builtin_amdgcn_readfirstlane(tid >> 6), fr = lane & 15, fq = lane >> 4;
    const int sc = item & 15, vh = (item >> 4) & 15, b = item >> 8;
    const int row0 = b * SEQ + sc * 512;
    int qcol, kcol, gcol, vcol, sscol;
    if (vh < 8) { qcol = 128 * vh; kcol = -1; gcol = 1024 + 128 * vh; vcol = 2048 + 128 * vh; sscol = 0; }
    else { const int j = (vh - 8) >> 1, e = (vh - 8) & 1; qcol = 3072 + 128 * j; kcol = 3584 + 128 * j; gcol = 5120 + 128 * j; vcol = 4096 + 256 * j + 128 * e; sscol = 1 + j; }
    const int ocol = (vh < 8) ? qcol : vcol;
    float* stp = ST + (size_t)item * 16384;
    f32x4 S[8];
#pragma unroll
    for (int j = 0; j < 8; ++j)
#pragma unroll
        for (int i = 0; i < 4; ++i) S[j][i] = OUT ? stp[(16 * w + 4 * fq + i) * 128 + 16 * j + fr] : 0.f;
    float btot0 = 0.f, btot1 = 0.f;
    u32x4 rg[2], rv[2], rk[2], rq[2];
    const int pr_ = tid >> 4, pc8 = tid & 15;
    const bf16_t* src0 = P + (size_t)(row0 + pr_) * LDP + 8 * pc8;
#define LA_ISSUE(c_) do { _Pragma("unroll") for (int i_ = 0; i_ < 2; ++i_) { const bf16_t* s_ = src0 + (size_t)(64 * (c_) + 32 * i_) * LDP; \
        rg[i_] = *(const u32x4*)(s_ + gcol); rv[i_] = *(const u32x4*)(s_ + vcol); if (kcol >= 0) rk[i_] = *(const u32x4*)(s_ + kcol); if (OUT) rq[i_] = *(const u32x4*)(s_ + qcol); } } while (0)
    LA_ISSUE(0);
#pragma unroll 1
    for (int c = 0; c < 8; ++c) {
#pragma unroll
        for (int i = 0; i < 2; ++i) {
            const int lo = (pr_ + 32 * i) * 256 + pc8 * 16;
            *(LAS u32x4*)(lds + L_RAWG + lo) = rg[i];
            *(LAS u32x4*)(lds + L_RAWV + lo) = rv[i];
            if (kcol >= 0) *(LAS u32x4*)(lds + L_RAWK + lo) = rk[i];
            if (OUT) *(LAS u32x4*)(lds + L_RAWQ + lo) = rq[i];
        }
        __syncthreads();
        if (c < 7) LA_ISSUE(c + 1);
        {
            float s0 = 0.f, s1 = 0.f;
#pragma unroll
            for (int j = 0; j < 8; ++j) { const unsigned gw = *(const LAS unsigned*)(lds + L_RAWG + (8 * w + j) * 256 + lane * 4); s0 += bf_lo(gw); s1 += bf_hi(gw); }
            *(LAS f32x2*)(lds + L_PSUM + (w * 128 + 2 * lane) * 4) = (f32x2){s0, s1};
        }
        __syncthreads();
        {
            float off0 = 0.f, off1 = 0.f, bref0 = 0.f, bref1 = 0.f, bl0 = 0.f, bl1 = 0.f;
#pragma unroll
            for (int ww = 0; ww < 8; ++ww) { const f32x2 p = *(const LAS f32x2*)(lds + L_PSUM + (ww * 128 + 2 * lane) * 4);
                if (ww < w) { off0 += p.x; off1 += p.y; } if (ww < 4) { bref0 += p.x; bref1 += p.y; } bl0 += p.x; bl1 += p.y; }
            float run0 = off0, run1 = off1;
            float ke0[8], ke1[8]; unsigned vv[8];
#pragma unroll
            for (int j = 0; j < 8; ++j) {
                const int t = 8 * w + j;
                const unsigned gw = *(const LAS unsigned*)(lds + L_RAWG + t * 256 + lane * 4);
                const float ga = bf_lo(gw), gb = bf_hi(gw);
                run0 += ga; run1 += gb;
                float kk0, kk1;
                if (kcol < 0) { kk0 = 1.f - __expf(ga); kk1 = 1.f - __expf(gb); }
                else { const unsigned kw = *(const LAS unsigned*)(lds + L_RAWK + t * 256 + lane * 4); kk0 = bf_lo(kw); kk1 = bf_hi(kw); }
                ke0[j] = kk0 * __expf(bl0 - run0); ke1[j] = kk1 * __expf(bl1 - run1);
                if (OUT) {
                    const unsigned qw = *(const LAS unsigned*)(lds + L_RAWQ + t * 256 + lane * 4);
                    *(LAS unsigned*)(lds + L_QM + t * 272 + lane * 4) = cvt_pk_bf16(bf_lo(qw) * __expf(run0 - bref0), bf_hi(qw) * __expf(run1 - bref1));
                    *(LAS unsigned*)(lds + L_KM + t * 272 + lane * 4) = cvt_pk_bf16(kk0 * __expf(bref0 - run0), kk1 * __expf(bref1 - run1));
                }
                vv[j] = *(const LAS unsigned*)(lds + L_RAWV + t * 256 + lane * 4);
            }
            u32x4 k0w, k1w, v0w, v1w;
            k0w.x = cvt_pk_bf16(ke0[0], ke0[1]); k0w.y = cvt_pk_bf16(ke0[2], ke0[3]); k0w.z = cvt_pk_bf16(ke0[4], ke0[5]); k0w.w = cvt_pk_bf16(ke0[6], ke0[7]);
            k1w.x = cvt_pk_bf16(ke1[0], ke1[1]); k1w.y = cvt_pk_bf16(ke1[2], ke1[3]); k1w.z = cvt_pk_bf16(ke1[4], ke1[5]); k1w.w = cvt_pk_bf16(ke1[6], ke1[7]);
            v0w.x = (vv[0] & 0xffffu) | (vv[1] << 16); v0w.y = (vv[2] & 0xffffu) | (vv[3] << 16); v0w.z = (vv[4] & 0xffffu) | (vv[5] << 16); v0w.w = (vv[6] & 0xffffu) | (vv[7] << 16);
            v1w.x = (vv[0] >> 16) | (vv[1] & 0xffff0000u); v1w.y = (vv[2] >> 16) | (vv[3] & 0xffff0000u); v1w.z = (vv[4] >> 16) | (vv[5] & 0xffff0000u); v1w.w = (vv[6] >> 16) | (vv[7] & 0xffff0000u);
            *(LAS u32x4*)(lds + L_KET + (2 * lane) * 144 + w * 16) = k0w; *(LAS u32x4*)(lds + L_KET + (2 * lane + 1) * 144 + w * 16) = k1w;
            *(LAS u32x4*)(lds + L_VT + (2 * lane) * 144 + w * 16) = v0w; *(LAS u32x4*)(lds + L_VT + (2 * lane + 1) * 144 + w * 16) = v1w;
            if (w == 0) { *(LAS f32x2*)(lds + L_EBREF + lane * 8) = (f32x2){__expf(bref0), __expf(bref1)}; *(LAS f32x2*)(lds + L_EBLAST + lane * 8) = (f32x2){__expf(bl0), __expf(bl1)}; }
            btot0 += bl0; btot1 += bl1;
        }
        __syncthreads();
        if (OUT) {
            {
                const f32x4 er = *(const LAS f32x4*)(lds + L_EBREF + (16 * w + 4 * fq) * 4);
#pragma unroll
                for (int j = 0; j < 8; ++j) { u32x2 o; o.x = cvt_pk_bf16(S[j][0] * er[0], S[j][1] * er[1]); o.y = cvt_pk_bf16(S[j][2] * er[2], S[j][3] * er[3]);
                    *(LAS u32x2*)(lds + L_ST + (16 * j + fr) * 272 + (16 * w + 4 * fq) * 2) = o; }
#pragma unroll
                for (int q = 0; q < 2; ++q) {
                    const int id = 2 * w + q, st = id >> 2, tt = id & 3;
                    f32x4 a = (f32x4){0.f, 0.f, 0.f, 0.f};
                    if (tt >= st) {
#pragma unroll
                        for (int kk = 0; kk < 4; ++kk) {
                            const bf16x8 xk = *(const LAS bf16x8*)(lds + L_KM + (16 * st + fr) * 272 + (32 * kk + 8 * fq) * 2);
                            const bf16x8 yq = *(const LAS bf16x8*)(lds + L_QM + (16 * tt + fr) * 272 + (32 * kk + 8 * fq) * 2);
                            a = __builtin_amdgcn_mfma_f32_16x16x32_bf16(xk, yq, a, 0, 0, 0);
                        }
                    }
                    const int t = 16 * tt + fr, s0 = 16 * st + 4 * fq;
                    u32x2 o; o.x = cvt_pk_bf16(s0 <= t ? a[0] : 0.f, s0 + 1 <= t ? a[1] : 0.f); o.y = cvt_pk_bf16(s0 + 2 <= t ? a[2] : 0.f, s0 + 3 <= t ? a[3] : 0.f);
                    *(LAS u32x2*)(lds + L_PB + t * 144 + s0 * 2) = o;
                }
            }
            __syncthreads();
#pragma unroll
            for (int tt = 0; tt < 4; ++tt) {
                f32x4 a = (f32x4){0.f, 0.f, 0.f, 0.f};
#pragma unroll
                for (int kk = 0; kk < 4; ++kk) {
                    const bf16x8 xs = *(const LAS bf16x8*)(lds + L_ST + (16 * w + fr) * 272 + (32 * kk + 8 * fq) * 2);
                    const bf16x8 yq = *(const LAS bf16x8*)(lds + L_QM + (16 * tt + fr) * 272 + (32 * kk + 8 * fq) * 2);
                    a = __builtin_amdgcn_mfma_f32_16x16x32_bf16(xs, yq, a, 0, 0, 0);
                }
#pragma unroll
                for (int ss = 0; ss < 2; ++ss) {
                    const bf16x8 xv = *(const LAS bf16x8*)(lds + L_VT + (16 * w + fr) * 144 + (32 * ss + 8 * fq) * 2);
                    const bf16x8 yp = *(const LAS bf16x8*)(lds + L_PB + (16 * tt + fr) * 144 + (32 * ss + 8 * fq) * 2);
                    a = __builtin_amdgcn_mfma_f32_16x16x32_bf16(xv, yp, a, 0, 0, 0);
                }
                float q2 = a[0] * a[0] + a[1] * a[1] + a[2] * a[2] + a[3] * a[3];
                q2 += __shfl_xor(q2, 16); q2 += __shfl_xor(q2, 32);
                if (fq == 0) *(LAS float*)(lds + L_RED + (w * 64 + 16 * tt + fr) * 4) = q2;
                u32x2 o; o.x = cvt_pk_bf16(a[0], a[1]); o.y = cvt_pk_bf16(a[2], a[3]);
                *(u32x2*)(P + (size_t)(row0 + 64 * c + 16 * tt + fr) * LDP + ocol + 16 * w + 4 * fq) = o;
            }
        }
        {
            const f32x4 el = *(const LAS f32x4*)(lds + L_EBLAST + (16 * w + 4 * fq) * 4);
            bf16x8 xk[2];
#pragma unroll
            for (int ss = 0; ss < 2; ++ss) xk[ss] = *(const LAS bf16x8*)(lds + L_KET + (16 * w + fr) * 144 + (32 * ss + 8 * fq) * 2);
#pragma unroll
            for (int j = 0; j < 8; ++j) {
                S[j] = S[j] * el;
#pragma unroll
                for (int ss = 0; ss < 2; ++ss) {
                    const bf16x8 yv = *(const LAS bf16x8*)(lds + L_VT + (16 * j + fr) * 144 + (32 * ss + 8 * fq) * 2);
                    S[j] = __builtin_amdgcn_mfma_f32_16x16x32_bf16(xk[ss], yv, S[j], 0, 0, 0);
                }
            }
        }
        __syncthreads();
        if (OUT) {
            if (tid < 64) { float tot = 0.f;
#pragma unroll
                for (int ww = 0; ww < 8; ++ww) tot += *(const LAS float*)(lds + L_RED + (ww * 64 + tid) * 4);
                atomicAdd(SS + (size_t)(row0 + 64 * c + tid) * 8 + sscol, tot); }
        }
    }
    if (!OUT) {
#pragma unroll
        for (int j = 0; j < 8; ++j)
#pragma unroll
            for (int i = 0; i < 4; ++i) stp[(16 * w + 4 * fq + i) * 128 + 16 * j + fr] = S[j][i];
        if (w == 0) *(f32x2*)(DSC + (size_t)item * 128 + 2 * lane) = (f32x2){__expf(btot0), __expf(btot1)};
    }
#undef LA_ISSUE
}


#define XB_TMO      128
#define XB_XCNT(j)  (256  + 64 * (j))
#define XB_XSUB(j)  (1280 + 64 * (j))
#define XB_XGEN(j)  (2304 + 64 * (j))
#define XB_TOP      3328
#define XB_TOPGEN   3392
#define XCD_BAR_WORDS 3456
#define XB_SPIN_CAP (1u << 18)
__device__ __forceinline__ unsigned xb_ld(unsigned* p)              { return __hip_atomic_load(p, __ATOMIC_RELAXED, __HIP_MEMORY_SCOPE_AGENT); }
__device__ __forceinline__ unsigned xb_add(unsigned* p, unsigned v) { return __hip_atomic_fetch_add(p, v, __ATOMIC_RELAXED, __HIP_MEMORY_SCOPE_AGENT); }
__device__ __forceinline__ unsigned xb_xcc_id() { return (unsigned)__builtin_amdgcn_s_getreg((3 << 11) | 20) & 0xFu; }
#define XB_SPIN(cond, bar) do { unsigned _sp = 0; while (cond) { __builtin_amdgcn_s_sleep(1); \
    if ((++_sp & 255u) == 0u) { if (xb_ld(&(bar)[XB_TMO])) break; if (_sp > XB_SPIN_CAP) { atomicAdd(&(bar)[XB_TMO], 1u); break; } } } } while (0)
struct XcdBarrier { unsigned* bar; unsigned x; volatile LAS unsigned* st; };
__device__ __forceinline__ XcdBarrier xcd_barrier_post(unsigned* bar, volatile LAS unsigned* st) {
    XcdBarrier b; b.bar = bar; b.x = xb_xcc_id(); b.st = st;
    if (threadIdx.x == 0) (void)xb_add(&bar[XB_XCNT(b.x)], 1u);
    return b;
}
__device__ __forceinline__ void xcd_barrier_complete(unsigned* bar, unsigned x, unsigned& nloc, unsigned& nx) {
    const unsigned G = gridDim.x * gridDim.y * gridDim.z;
    unsigned sum, cnt, mine, sp = 0u;
    for (;;) {
        sum = 0u; cnt = 0u; mine = 0u;
#pragma unroll
        for (unsigned j = 0; j < 16; ++j) { const unsigned c = xb_ld(&bar[XB_XCNT(j)]); sum += c; cnt += (c > 0u) ? 1u : 0u; mine = (j == x) ? c : mine; }
        if (sum == G) break;
        __builtin_amdgcn_s_sleep(1);
        if ((++sp & 255u) == 0u) { if (xb_ld(&bar[XB_TMO])) break; if (sp > XB_SPIN_CAP) { atomicAdd(&bar[XB_TMO], 1u); break; } }
    }
    nloc = mine > 0u ? mine : 1u; nx = cnt > 0u ? cnt : 1u;
}
__device__ __forceinline__ void xcd_barrier(const XcdBarrier& b) {
    asm volatile("s_waitcnt vmcnt(0)" ::: "memory");
    __syncthreads();
    if (threadIdx.x == 0) {
        unsigned* bar = b.bar;
        __builtin_amdgcn_s_waitcnt(0);
        unsigned nloc = b.st[0], nx = b.st[1];
        if (nloc == 0u) { xcd_barrier_complete(bar, b.x, nloc, nx); b.st[0] = nloc; b.st[1] = nx; }
        const unsigned old = xb_add(&bar[XB_XSUB(b.x)], 1u);
        const unsigned gen = old / nloc;
        if (old + 1u == (gen + 1u) * nloc) {
            __builtin_amdgcn_fence(__ATOMIC_RELEASE, "agent");
            asm volatile("s_waitcnt vmcnt(0)" ::: "memory");
            const unsigned og = xb_add(&bar[XB_TOP], 1u);
            const unsigned tg = og / nx;
            if (og + 1u == (tg + 1u) * nx) xb_add(&bar[XB_TOPGEN], 1u);
            else XB_SPIN(xb_ld(&bar[XB_TOPGEN]) == tg, bar);
            __builtin_amdgcn_fence(__ATOMIC_ACQUIRE, "agent");
            xb_add(&bar[XB_XGEN(b.x)], 1u);
            asm volatile("s_waitcnt vmcnt(0)" ::: "memory");
        } else {
            XB_SPIN(xb_ld(&bar[XB_XGEN(b.x)]) == gen, bar);
            __builtin_amdgcn_fence(__ATOMIC_ACQUIRE, "agent");
            asm volatile("s_waitcnt vmcnt(0)" ::: "memory");
        }
    }
    __syncthreads();
}

struct Args { const float* x; const float* c; const float* ada_w; const float* ada_b; const float* norm_w; const float* w_in; const float* lb_logits; const float* hnw;
              const float* alpha_w; const float* alpha_b; const float* gnw; const float* w_branch; const float* w_out; const float* fnw; float* out; unsigned char* ws; };

#ifndef PROBE_MASK
#define PROBE_MASK 0
#endif
#define PH_END(id) do { if ((id) == 0) { grid.sync(); xbar = xcd_barrier_post((unsigned*)(ws + WS_BAR), (volatile LAS unsigned*)(lds + L_BARST)); } else xcd_barrier(xbar); if (PROBE_MASK) { const unsigned long long now_ = __builtin_amdgcn_s_memrealtime(); if ((PROBE_MASK >> (id)) & 1) tacc += now_ - tprev; tprev = now_; } } while (0)
__global__ void __launch_bounds__(512, 2) fwd_megakernel(Args a) {
    extern __shared__ __attribute__((aligned(16))) unsigned char lds_raw[];
    LAS unsigned char* lds = (LAS unsigned char*)lds_raw;
    cg::grid_group grid = cg::this_grid();
    const int tid = threadIdx.x, lane = tid & 63, wave = __builtin_amdgcn_readfirstlane(tid >> 6);
    const int G = gridDim.x, bid = blockIdx.x;
    const int gw = bid * 8 + wave, NGW = G * 8;
    unsigned char* ws = a.ws;
    XcdBarrier xbar; xbar.bar = nullptr; xbar.x = 0; xbar.st = nullptr;
    if (tid < 2) *(volatile LAS unsigned*)(lds + L_BARST + 4 * tid) = 0u;
    if (bid == 0) for (int i = tid; i < XCD_BAR_WORDS; i += 512) __hip_atomic_store((unsigned*)(ws + WS_BAR) + i, 0u, __ATOMIC_RELAXED, __HIP_MEMORY_SCOPE_AGENT);
    unsigned long long tacc = 0ull, tprev = PROBE_MASK ? __builtin_amdgcn_s_memrealtime() : 0ull;
    float* mod = (float*)(ws + WS_MOD); float* lbv = (float*)(ws + WS_LB); float* SS = (float*)(ws + WS_SS); float* DSC = (float*)(ws + WS_DSC);
    bf16_t* D1 = (bf16_t*)(ws + WS_D1); bf16_t* P = (bf16_t*)(ws + WS_P);
    bf16_t* H = (bf16_t*)((unsigned char*)a.out + OUT_H); float* ST = (float*)((unsigned char*)a.out + OUT_ST);

    for (int jb = bid; jb < 192; jb += G) {
        LAS float* cact = (LAS float*)lds; LAS float* red = cact + 2048;
        for (int i = tid; i < 2048; i += 512) { const float v = a.c[i]; cact[i] = v * fsigmoid(v); }
        __syncthreads();
        const int l = jb / 96, j0 = (jb % 96) * 32, jj = tid & 31, seg = tid >> 5;
        const float* wp = a.ada_w + (size_t)l * 1024 * 3072 + j0 + jj;
        float a0 = 0.f, a1 = 0.f;
#pragma unroll 8
        for (int i = seg * 64; i < seg * 64 + 64; ++i) { const float wv = wp[(size_t)i * 3072]; a0 += cact[i] * wv; a1 += cact[1024 + i] * wv; }
        red[(seg * 32 + jj) * 2] = a0; red[(seg * 32 + jj) * 2 + 1] = a1;
        __syncthreads();
        if (tid < 64) { const int j2 = tid & 31, b = tid >> 5; float s = 0.f;
#pragma unroll
            for (int sg = 0; sg < 16; ++sg) s += red[(sg * 32 + j2) * 2 + b];
            mod[(l * 2 + b) * 3072 + j0 + j2] = s + a.ada_b[l * 3072 + j0 + j2]; }
        __syncthreads();
    }
    for (int j = bid * 512 + tid; j < 1024; j += G * 512) {
        const float l0 = a.lb_logits[j], l1 = a.lb_logits[1024 + j], mx = fmaxf(l0, l1), e0 = __expf(l0 - mx), e1 = __expf(l1 - mx);
        const float p0 = e0 / (e0 + e1), p1 = e1 / (e0 + e1);
        lbv[j] = 0.f; lbv[1024 + j] = fminf(fmaxf((p0 + p1) - p0, 0.f), 1.f);
    }
    {
        LAS float* scr = (LAS float*)(lds + wave * 8448);
        for (int it = gw; it < 2 * 6400; it += NGW) {
            const int l = it / 6400; int r = it % 6400;
            bf16_t* WT = (bf16_t*)(ws + WS_W + (size_t)l * W_LAYER);
            const float* win = a.w_in + (size_t)l * 1024 * DIN;
            if (r < 1536) { tr_item(win, DIN, 0, WT, 0, scr, r, 96, lane); continue; } r -= 1536;
            if (r < 1024) { tr_item(win, DIN, 4096, WT, 3072, scr, r, 64, lane); continue; } r -= 1024;
            if (r < 256) { tr_item_la(win, a.alpha_w + (size_t)l * 16 * 512, WT, 5120, scr, r, lane); continue; } r -= 256;
            if (r < 512) { tr_item(win, DIN, 3072, WT, 5632, scr, r, 32, lane); continue; } r -= 512;
            if (r < 512) { tr_item(win, DIN, 6144, WT, 6656, scr, r, 32, lane); continue; } r -= 512;
            if (r < 1024) { tr_item(win, DIN, 7184, WT, 7680, scr, r, 64, lane); continue; } r -= 1024;
            if (r < 512) { tr_item(a.w_branch + (size_t)l * 2 * 1048576, 1024, 0, WT, 9728, scr, r, 32, lane); continue; } r -= 512;
            if (r < 512) { tr_item(a.w_branch + (size_t)l * 2 * 1048576 + 1048576, 1024, 0, WT, 10752, scr, r, 32, lane); continue; } r -= 512;
            tr_item(a.w_out + (size_t)l * 1048576, 1024, 0, WT, 11776, scr, r, 32, lane);
        }
    }
    PH_END(0);

#pragma unroll 1
    for (int l = 0; l < 2; ++l) {
        const bf16_t* WT = (const bf16_t*)(ws + WS_W + (size_t)l * W_LAYER);
        const float* modl = mod + l * 2 * 3072;
        { const int tid = opaque_tid(), lane = tid & 63, wave = __builtin_amdgcn_readfirstlane(tid >> 6), gw = bid * 8 + wave;
        for (int i = bid * 512 + tid; i < MROWS * 8; i += G * 512) SS[i] = 0.f;
        for (int m = gw; m < MROWS; m += NGW) {
            const int b = m >> 13;
            const f32x4* xr = (const f32x4*)(a.x + (size_t)m * DM) + lane;
            f32x4 v[4]; float s = 0.f;
#pragma unroll
            for (int j = 0; j < 4; ++j) v[j] = xr[64 * j];
            if (l == 1) { const u32x2* dr = (const u32x2*)(D1 + (size_t)m * DM) + lane;
#pragma unroll
                for (int j = 0; j < 4; ++j) { const u32x2 d = dr[64 * j]; v[j][0] += bf_lo(d.x); v[j][1] += bf_hi(d.x); v[j][2] += bf_lo(d.y); v[j][3] += bf_hi(d.y); } }
#pragma unroll
            for (int j = 0; j < 4; ++j) s += (v[j][0] * v[j][0] + v[j][1] * v[j][1]) + (v[j][2] * v[j][2] + v[j][3] * v[j][3]);
            const float rstd = rsqrtf(wave_sum(s) * (1.f / 1024.f) + EPS);
            const float* mb = modl + b * 3072; const float* nw = a.norm_w + l * 1024;
            u32x2* hr = (u32x2*)(H + (size_t)m * DM) + lane;
#pragma unroll
            for (int j = 0; j < 4; ++j) { const int col = 4 * lane + 256 * j;
                const f32x4 nv = *(const f32x4*)(nw + col), sh = *(const f32x4*)(mb + col), sc = *(const f32x4*)(mb + 1024 + col);
                const f32x4 h = v[j] * rstd * nv * (sc + 1.f) + sh;
                u32x2 o; o.x = cvt_pk_bf16(h[0], h[1]); o.y = cvt_pk_bf16(h[2], h[3]); hr[64 * j] = o; }
        } }
        PH_END(1);
        { pg8::Gemm g{H, WT, 1024, 1024}; pg8::StaticOrder S; S.init(MROWS, 5632, G, bid);
          EpiA1 E{P, lbv + l * 1024, a.alpha_b + l * 512};
          pg8::gemm_phase<EpiA1, pg8::StaticOrder>(lds, g, S, E); }
        PH_END(2);
        for (int item = bid; item < 512; item += G) la_item<false>(lds, P, ST, DSC, SS, item);
        PH_END(3);
        for (int gt = bid * 512 + opaque_tid(); gt < 32 * 4096; gt += G * 512) {
            const int chain = gt >> 12, e = gt & 4095, k = e >> 5;
            f32x4* p0 = (f32x4*)(ST + (size_t)chain * 16 * 16384) + e; const float* d0 = DSC + (size_t)chain * 16 * 128 + k;
            f32x4 cur[15]; float dd[15];
#pragma unroll
            for (int sc = 0; sc < 15; ++sc) { cur[sc] = p0[(size_t)sc * 4096]; dd[sc] = d0[sc * 128]; }
            f32x4 carry = (f32x4){0.f, 0.f, 0.f, 0.f};
#pragma unroll
            for (int sc = 0; sc < 16; ++sc) { p0[(size_t)sc * 4096] = carry; if (sc < 15) carry = carry * dd[sc] + cur[sc]; }
        }
        PH_END(4);
        for (int item = bid; item < 512; item += G) la_item<true>(lds, P, ST, DSC, SS, item);
        PH_END(5);
        { pg8::Gemm g{H, WT + (size_t)5632 * 1024, 1024, 1024}; pg8::StaticOrder S; S.init(MROWS, 4096, G, bid);
          EpiA2 E{P, SS, a.hnw + l * 1024, a.gnw + l * 256};
          pg8::gemm_phase<EpiA2, pg8::StaticOrder>(lds, g, S, E); }
        PH_END(6);
        { pg8::Gemm g{P, WT + (size_t)9728 * 1024, LDP, 1024}; pg8::BranchOrder S; S.s.init(MROWS, 1024, G, bid);
          EpiC1 E{P};
          pg8::gemm_phase<EpiC1, pg8::BranchOrder>(lds, g, S, E); }
        PH_END(7);
        { pg8::Gemm g{P + 3072, WT + (size_t)11776 * 1024, LDP, 1024}; pg8::StaticOrder S; S.init(MROWS, 1024, G, bid);
          if (l == 0) { EpiC2a E{D1, modl}; pg8::gemm_phase<EpiC2a, pg8::StaticOrder>(lds, g, S, E); }
          else { EpiC2b E{a.x, D1, a.out, modl}; pg8::gemm_phase<EpiC2b, pg8::StaticOrder>(lds, g, S, E); } }
        PH_END(8);
    }
    for (int m = gw; m < MROWS; m += NGW) {
        f32x4* xr = (f32x4*)(a.out + (size_t)m * DM) + lane;
        f32x4 v[4]; float s = 0.f;
#pragma unroll
        for (int j = 0; j < 4; ++j) { v[j] = xr[64 * j]; s += (v[j][0] * v[j][0] + v[j][1] * v[j][1]) + (v[j][2] * v[j][2] + v[j][3] * v[j][3]); }
        const float rstd = rsqrtf(wave_sum(s) * (1.f / 1024.f) + EPS);
#pragma unroll
        for (int j = 0; j < 4; ++j) { const f32x4 nv = *(const f32x4*)(a.fnw + 4 * lane + 256 * j); xr[64 * j] = v[j] * rstd * nv; }
    }
    if (PROBE_MASK) { if ((PROBE_MASK >> 9) & 1) tacc += __builtin_amdgcn_s_memrealtime() - tprev;
        if (bid == 0 && threadIdx.x == 0) { const unsigned long long t0 = __builtin_amdgcn_s_memrealtime(); while (__builtin_amdgcn_s_memrealtime() - t0 < 4ull * tacc) __builtin_amdgcn_s_sleep(32); } }
}

extern "C" void kernel_launch(void* const* d_in, const int* in_sizes, int n_in, void* d_out, int out_size, void* d_ws, size_t ws_size, hipStream_t stream) {
    static int grid = 0;
    if (grid == 0) {
        if (n_in != 14 || out_size != MROWS * DM || ws_size < WS_END) { fprintf(stderr, "kernel_launch: unexpected problem (n_in %d, out %d, ws %zu < %zu)\n", n_in, out_size, ws_size, (size_t)WS_END); grid = -1; return; }
        int dev = 0, cus = 0, per_cu = 0;
        if (hipGetDevice(&dev) != hipSuccess || hipDeviceGetAttribute(&cus, hipDeviceAttributeMultiprocessorCount, dev) != hipSuccess) { grid = -1; return; }
        if (hipFuncSetAttribute((const void*)fwd_megakernel, hipFuncAttributeMaxDynamicSharedMemorySize, LDS_BYTES) != hipSuccess) { fprintf(stderr, "kernel_launch: hipFuncSetAttribute failed\n"); grid = -1; return; }
        if (hipOccupancyMaxActiveBlocksPerMultiprocessor(&per_cu, (const void*)fwd_megakernel, 512, LDS_BYTES) != hipSuccess || per_cu < 1) { fprintf(stderr, "kernel_launch: occupancy query says %d\n", per_cu); grid = -1; return; }
        grid = cus;
    }
    if (grid < 0) return;
    Args a{};
    a.x = (const float*)d_in[0]; a.c = (const float*)d_in[1]; a.ada_w = (const float*)d_in[2]; a.ada_b = (const float*)d_in[3]; a.norm_w = (const float*)d_in[4]; a.w_in = (const float*)d_in[5];
    a.lb_logits = (const float*)d_in[6]; a.hnw = (const float*)d_in[7]; a.alpha_w = (const float*)d_in[8]; a.alpha_b = (const float*)d_in[9]; a.gnw = (const float*)d_in[10];
    a.w_branch = (const float*)d_in[11]; a.w_out = (const float*)d_in[12]; a.fnw = (const float*)d_in[13]; a.out = (float*)d_out; a.ws = (unsigned char*)d_ws;
    void* args[] = {&a};
    const hipError_t e = hipLaunchCooperativeKernel((const void*)fwd_megakernel, dim3(grid), dim3(512), args, LDS_BYTES, stream);
    if (e != hipSuccess) fprintf(stderr, "kernel_launch: cooperative launch failed: %s (grid %d)\n", hipGetErrorString(e), grid);
}
```

```cpp
#include <hip/hip_runtime.h>
#include <hip/hip_cooperative_groups.h>
#include <cstdio>
#include <cstdint>
namespace cg = cooperative_groups;
#ifndef PROBE_LA
#define PROBE_LA 0
#endif

#define LAS __attribute__((address_space(3)))
typedef unsigned short bf16_t;
typedef short bf16x8 __attribute__((ext_vector_type(8)));
typedef float f32x4 __attribute__((ext_vector_type(4)));
typedef float f32x2 __attribute__((ext_vector_type(2)));
typedef unsigned u32x4 __attribute__((ext_vector_type(4)));
typedef unsigned u32x2 __attribute__((ext_vector_type(2)));

constexpr int MROWS = 16384, DM = 1024, SEQ = 8192, LDP = 5632, DIN = 9232;
constexpr float EPS = 1e-6f;
constexpr size_t WS_MOD = 4096, WS_LB = 53248, WS_SS = 65536, WS_DSC = 589824, WS_BAR = 860160, WS_W = 1048576, W_LAYER = 26214400;
constexpr size_t WS_D1 = WS_W + 2 * W_LAYER, WS_P = WS_D1 + (size_t)MROWS * DM * 2, WS_END = WS_P + (size_t)MROWS * LDP * 2;
constexpr size_t OUT_H = 0, OUT_ST = 33554432;
constexpr int LDS_BYTES = 147456, L_BARST = 146432;

__device__ __forceinline__ unsigned cvt_pk_bf16(float lo, float hi) { unsigned r; asm volatile("v_cvt_pk_bf16_f32 %0, %1, %2" : "=v"(r) : "v"(lo), "v"(hi)); return r; }
__device__ __forceinline__ float bf_lo(unsigned w) { return __uint_as_float(w << 16); }
__device__ __forceinline__ float bf_hi(unsigned w) { return __uint_as_float(w & 0xffff0000u); }
__device__ __forceinline__ float fsigmoid(float v) { return __builtin_amdgcn_rcpf(1.f + __expf(-v)); }
__device__ __forceinline__ int opaque_tid() { int t = threadIdx.x; asm volatile("" : "+v"(t)); return t; }
__device__ __forceinline__ float wave_sum(float v) {
#pragma unroll
    for (int o = 1; o < 64; o <<= 1) v += __shfl_xor(v, o);
    return v;
}

namespace pg8 {
constexpr int BM = 256, BK = 64, HALF = 128, HTB = HALF * BK * 2, STAGE_BYTES = 8 * HTB, NXCD = 8, WGM = 8;
__host__ __device__ __forceinline__ int lds_byte(int r, int c) { const int st = (r >> 4) * 2 + (c >> 5), rr = r & 15, cc = c & 31, ob = rr * 64 + cc * 2; return st * 1024 + (ob ^ (((ob >> 9) & 1) << 5)); }
__host__ __device__ __forceinline__ void stage_rc(int b, int& R, int& C) { const int st = b / 1024, sb = b % 1024, swz = sb ^ (((sb >> 9) & 1) << 5); R = (st >> 1) * 16 + swz / 64; C = (st & 1) * 32 + (swz % 64) / 2; }
__host__ __device__ __forceinline__ int perm32(int rho) { const int n = rho >> 4, i = rho & 15; return 8 * (i >> 2) + 4 * n + (i & 3); }

struct Unit { int pm, pn, br; unsigned ao, bo; };
struct Gemm { const bf16_t* A; const bf16_t* Bt; int lda, K; };

struct StaticOrder {
    int nM, nN, nwg, G, c;
    __host__ __device__ void init(int M, int N, int G_, int c_) { nM = M / BM; nN = N / BM; nwg = nM * nN; G = G_; c = c_; }
    __host__ __device__ bool next(int i, Unit& u) const {
        const long L = (long)i * G + c; if (L >= nwg) return false;
        int wgid = (int)L; { const int q = nwg / NXCD, r = nwg % NXCD, xcd = wgid % NXCD, off = wgid / NXCD; wgid = (xcd < r ? xcd * (q + 1) : r * (q + 1) + (xcd - r) * q) + off; }
        const int nig = WGM * nN, gid = wgid / nig, fm = gid * WGM, gsz = (nM - fm) < WGM ? (nM - fm) : WGM;
        u.pm = fm + ((wgid % nig) % gsz); u.pn = (wgid % nig) / gsz; u.br = 0; u.ao = 0u; u.bo = 0u; return true;
    }
};
struct BranchOrder {
    StaticOrder s;
    __host__ __device__ bool next(int i, Unit& u) const { if (!s.next(i >> 1, u)) return false; u.br = i & 1; u.ao = (i & 1) ? 4096u * 2u : 0u; u.bo = (i & 1) ? 1024u * 1024u * 2u : 0u; return true; }
};

template <class Epi, class Sched>
__device__ __forceinline__ void gemm_phase(LAS unsigned char* lds, const Gemm g, const Sched& S, const Epi& E) {
    const int tid = opaque_tid(), wid = __builtin_amdgcn_readfirstlane(tid >> 6), lane = tid & 63, wr = wid >> 2, wc = wid & 3, fr = lane & 15, fq = lane >> 4;
    const int K = g.K, nt = K / BK, lda = g.lda;
    unsigned voffA[2], voffB[2];
#pragma unroll
    for (int i = 0; i < 2; ++i) { int R, C; stage_rc(tid * 16 + i * 8192, R, C); const int Rb = Epi::PERM ? ((R & ~31) + perm32(R & 31)) : R;
        voffA[i] = (unsigned)(R * lda + C) * 2u; voffB[i] = (unsigned)(Rb * K + C) * 2u;
        asm volatile("" : "+v"(voffA[i]), "+v"(voffB[i])); }
    const size_t kstep = (size_t)(BK * 2);
    const size_t hA = (size_t)HALF * lda * 2, tA = 2 * hA, hB = (size_t)HALF * K * 2, tB = 2 * hB;
    const unsigned ldsw = (unsigned)wid * 1024u;
    const int aoff = lds_byte(wr * 64 + fr, fq * 8), boff = lds_byte(wc * 32 + fr, fq * 8);
#define PG8_SA(b, h) (((b) * 2 + (h)) * HTB)
#define PG8_SB(b, h) ((4 + (b) * 2 + (h)) * HTB)
#define PG8_STAGE(bufoff, gbase, voff) do { _Pragma("unroll") for (int _i = 0; _i < 2; ++_i) \
        __builtin_amdgcn_global_load_lds((const unsigned*)((const char*)(gbase) + (voff)[_i]), (LAS unsigned*)(lds + (bufoff) + ldsw + _i * 8192), 16, 0, 0); } while (0)
#define PG8_LDA(dst, b, h) do { _Pragma("unroll") for (int m = 0; m < 4; ++m) _Pragma("unroll") for (int k = 0; k < 2; ++k) dst[m][k] = *(const LAS bf16x8*)(lds + PG8_SA(b, h) + aoff + m * 2048 + k * 1024); } while (0)
#define PG8_LDB(dst, b, h) do { _Pragma("unroll") for (int n = 0; n < 2; ++n) _Pragma("unroll") for (int k = 0; k < 2; ++k) dst[n][k] = *(const LAS bf16x8*)(lds + PG8_SB(b, h) + boff + n * 2048 + k * 1024); } while (0)
#define PG8_MMA(ai, bj, At, Bt) do { __builtin_amdgcn_s_setprio(1); _Pragma("unroll") for (int m = 0; m < 4; ++m) _Pragma("unroll") for (int n = 0; n < 2; ++n) _Pragma("unroll") for (int k = 0; k < 2; ++k) \
        acc[ai][bj][m][n] = __builtin_amdgcn_mfma_f32_16x16x32_bf16(Bt[n][k], At[m][k], acc[ai][bj][m][n], 0, 0, 0); __builtin_amdgcn_s_setprio(0); } while (0)
#define PG8_WAIT_V(n) asm volatile("s_waitcnt vmcnt(" #n ")" ::: "memory")
#define PG8_WAIT_L(n) asm volatile("s_waitcnt lgkmcnt(" #n ")" ::: "memory")
#define PG8_BAR __builtin_amdgcn_s_barrier()
#define PG8_SCHED __builtin_amdgcn_sched_barrier(0)
    Unit cur, nxt; int ui = 0;
    if (!S.next(0, cur)) return;
    f32x4 acc[2][2][4][2];
#pragma unroll
    for (int a = 0; a < 2; ++a)
#pragma unroll
        for (int b = 0; b < 2; ++b)
#pragma unroll
            for (int m = 0; m < 4; ++m)
#pragma unroll
                for (int n = 0; n < 2; ++n) acc[a][b][m][n] = (f32x4){0.f, 0.f, 0.f, 0.f};
    bf16x8 At[4][2], B0[2][2], B1[2][2];
    const char* cA = (const char*)g.A + (size_t)cur.pm * tA + cur.ao; const char* cB = (const char*)g.Bt + (size_t)cur.pn * tB + cur.bo;
    PG8_STAGE(PG8_SB(0, 0), cB, voffB); PG8_STAGE(PG8_SB(0, 1), cB + hB, voffB); PG8_STAGE(PG8_SA(0, 0), cA, voffA); PG8_STAGE(PG8_SA(0, 1), cA + hA, voffA);
    if (wr == 1) PG8_BAR;
    PG8_WAIT_V(2); PG8_BAR;
    PG8_STAGE(PG8_SB(1, 0), cB + kstep, voffB); PG8_STAGE(PG8_SA(1, 0), cA + kstep, voffA); PG8_STAGE(PG8_SB(1, 1), cB + hB + kstep, voffB);
    PG8_WAIT_V(6); PG8_BAR;
    for (;;) {
        const bool has_next = S.next(ui + 1, nxt);
        const char* nA = has_next ? (const char*)g.A + (size_t)nxt.pm * tA + nxt.ao : cA; const char* nB = has_next ? (const char*)g.Bt + (size_t)nxt.pn * tB + nxt.bo : cB;
        for (int t = 0; t < nt; t += 2) {
            const bool last = (t == nt - 2);
            const char* a1 = cA + (size_t)(t + 1) * kstep;
            const char* a2 = last ? nA : cA + (size_t)(t + 2) * kstep; const char* b2 = last ? nB : cB + (size_t)(t + 2) * kstep;
            const char* a3 = a2 + kstep; const char* b3 = b2 + kstep;
            PG8_LDB(B0, 0, 0); PG8_LDB(B1, 0, 1); PG8_SCHED; PG8_LDA(At, 0, 0); PG8_STAGE(PG8_SA(1, 1), a1 + hA, voffA);
            PG8_WAIT_V(8); PG8_WAIT_L(0); PG8_BAR; PG8_MMA(0, 0, At, B0); PG8_MMA(0, 1, At, B1); PG8_BAR; PG8_SCHED;
            PG8_LDA(At, 0, 1); PG8_STAGE(PG8_SB(0, 0), b2, voffB); PG8_STAGE(PG8_SB(0, 1), b2 + hB, voffB); PG8_STAGE(PG8_SA(0, 0), a2, voffA);
            PG8_WAIT_V(8); PG8_WAIT_L(0); PG8_BAR; PG8_MMA(1, 0, At, B0); PG8_MMA(1, 1, At, B1); PG8_BAR; PG8_SCHED;
            PG8_LDB(B0, 1, 0); PG8_LDB(B1, 1, 1); PG8_SCHED; PG8_LDA(At, 1, 0); PG8_STAGE(PG8_SA(0, 1), a2 + hA, voffA);
            PG8_WAIT_V(8); PG8_WAIT_L(0); PG8_BAR; PG8_MMA(0, 0, At, B0); PG8_MMA(0, 1, At, B1); PG8_BAR; PG8_SCHED;
            PG8_LDA(At, 1, 1); PG8_STAGE(PG8_SB(1, 0), b3, voffB); PG8_STAGE(PG8_SB(1, 1), b3 + hB, voffB); PG8_STAGE(PG8_SA(1, 0), a3, voffA);
            PG8_WAIT_V(8); PG8_WAIT_L(0); PG8_BAR; PG8_MMA(1, 0, At, B0); PG8_MMA(1, 1, At, B1); PG8_BAR; PG8_SCHED;
        }
        if (wr == 0) PG8_BAR;
        E(acc, cur, wr, wc, fr, fq);
        if (!has_next) break;
#pragma unroll
        for (int a = 0; a < 2; ++a)
#pragma unroll
            for (int b = 0; b < 2; ++b)
#pragma unroll
                for (int m = 0; m < 4; ++m)
#pragma unroll
                    for (int n = 0; n < 2; ++n) acc[a][b][m][n] = (f32x4){0.f, 0.f, 0.f, 0.f};
        cur = nxt; cA = nA; cB = nB; ++ui;
        if (wr == 1) PG8_BAR;
    }
    PG8_WAIT_V(0);
    PG8_BAR;
#undef PG8_SA
#undef PG8_SB
#undef PG8_STAGE
#undef PG8_LDA
#undef PG8_LDB
#undef PG8_MMA
#undef PG8_WAIT_V
#undef PG8_WAIT_L
#undef PG8_BAR
#undef PG8_SCHED
}
}
using pg8::Unit;

__device__ __forceinline__ void unpack8(const u32x4 w, float (&o)[8]) { o[0] = bf_lo(w.x); o[1] = bf_hi(w.x); o[2] = bf_lo(w.y); o[3] = bf_hi(w.y); o[4] = bf_lo(w.z); o[5] = bf_hi(w.z); o[6] = bf_lo(w.w); o[7] = bf_hi(w.w); }
__device__ __forceinline__ u32x4 pack8(const float (&v)[8]) { u32x4 w; w.x = cvt_pk_bf16(v[0], v[1]); w.y = cvt_pk_bf16(v[2], v[3]); w.z = cvt_pk_bf16(v[4], v[5]); w.w = cvt_pk_bf16(v[6], v[7]); return w; }

struct EpiA1 {
    static constexpr bool PERM = true;
    bf16_t* P; const float* lb; const float* ab;
    __device__ __forceinline__ void operator()(const f32x4 (&acc)[2][2][4][2], const Unit& u, int wr, int wc, int fr, int fq) const {
        const int pn = u.pn;
        const int type = pn < 4 ? 0 : pn < 8 ? 1 : pn < 12 ? 2 : pn < 14 ? 3 : pn < 20 ? 2 : 4;
        const int row0 = u.pm * 256 + wr * 64 + fr, colb = pn * 256 + wc * 32 + 8 * fq;
#pragma unroll
        for (int bj = 0; bj < 2; ++bj) {
            const int col = colb + bj * 128;
            float pr[8];
#pragma unroll
            for (int e = 0; e < 8; ++e) pr[e] = 0.f;
            if (type == 1) { const f32x4 p0 = *(const f32x4*)(lb + col - 1024), p1 = *(const f32x4*)(lb + col - 1024 + 4); pr[0] = p0[0]; pr[1] = p0[1]; pr[2] = p0[2]; pr[3] = p0[3]; pr[4] = p1[0]; pr[5] = p1[1]; pr[6] = p1[2]; pr[7] = p1[3]; }
            if (type == 4) { const f32x4 p0 = *(const f32x4*)(ab + col - 5120), p1 = *(const f32x4*)(ab + col - 5120 + 4); pr[0] = p0[0]; pr[1] = p0[1]; pr[2] = p0[2]; pr[3] = p0[3]; pr[4] = p1[0]; pr[5] = p1[1]; pr[6] = p1[2]; pr[7] = p1[3]; }
#pragma unroll
            for (int ai = 0; ai < 2; ++ai)
#pragma unroll
                for (int m = 0; m < 4; ++m) {
                    const int row = row0 + ai * 128 + m * 16;
                    float v[8];
#pragma unroll
                    for (int e = 0; e < 4; ++e) { v[e] = acc[ai][bj][m][0][e]; v[4 + e] = acc[ai][bj][m][1][e]; }
                    if (type == 0) {
#pragma unroll
                        for (int e = 0; e < 8; ++e) v[e] = v[e] * fsigmoid(v[e]);
                    } else if (type == 1) {
#pragma unroll
                        for (int e = 0; e < 8; ++e) { const float f = pr[e] + (1.f - pr[e]) * fsigmoid(v[e]); v[e] = __log2f(fmaxf(f, 1e-20f)); }
                    } else if (type == 3) {
#pragma unroll
                        for (int e = 0; e < 8; ++e) v[e] *= 0.08838834764831845f;
                    } else if (type == 4) {
#pragma unroll
                        for (int e = 0; e < 8; ++e) { const float z = v[e] + pr[e]; v[e] = (fminf(z, 0.f) - __logf(1.f + __expf(-fabsf(z)))) * (0.0625f * 1.4426950408889634f); }
                    }
                    *(u32x4*)(P + (size_t)row * LDP + col) = pack8(v);
                }
        }
    }
};
struct EpiA2 {
    static constexpr bool PERM = true;
    bf16_t* P; const float* SS; const float* hnw; const float* gnw;
    __device__ __forceinline__ void operator()(const f32x4 (&acc)[2][2][4][2], const Unit& u, int wr, int wc, int fr, int fq) const {
        const int pn = u.pn;
        const int row0 = u.pm * 256 + wr * 64 + fr, cw = wc * 32 + 8 * fq;
#pragma unroll
        for (int bj = 0; bj < 2; ++bj) {
            const int cin = cw + bj * 128;
            float nw[8];
#pragma unroll
            for (int e = 0; e < 8; ++e) nw[e] = 1.f;
            int dcol;
            if (pn < 4) { dcol = pn * 256 + cin; const f32x4 p0 = *(const f32x4*)(hnw + dcol), p1 = *(const f32x4*)(hnw + dcol + 4); nw[0] = p0[0]; nw[1] = p0[1]; nw[2] = p0[2]; nw[3] = p0[3]; nw[4] = p1[0]; nw[5] = p1[1]; nw[6] = p1[2]; nw[7] = p1[3]; }
            else if (pn < 8) { dcol = 4096 + (pn - 4) * 256 + cin; const f32x4 p0 = *(const f32x4*)(gnw + cin), p1 = *(const f32x4*)(gnw + cin + 4); nw[0] = p0[0]; nw[1] = p0[1]; nw[2] = p0[2]; nw[3] = p0[3]; nw[4] = p1[0]; nw[5] = p1[1]; nw[6] = p1[2]; nw[7] = p1[3]; }
            else dcol = 1024 + (pn - 8) * 256 + cin;
#pragma unroll
            for (int ai = 0; ai < 2; ++ai)
#pragma unroll
                for (int m = 0; m < 4; ++m) {
                    const int row = row0 + ai * 128 + m * 16;
                    float v[8];
#pragma unroll
                    for (int e = 0; e < 4; ++e) { v[e] = acc[ai][bj][m][0][e]; v[4 + e] = acc[ai][bj][m][1][e]; }
                    bf16_t* dst = P + (size_t)row * LDP + dcol;
                    if (pn < 8) {
                        const float ssv = (pn < 4) ? SS[row * 8] : SS[row * 8 + 1 + (pn - 4)];
                        const float rstd = rsqrtf(ssv * ((pn < 4) ? (1.f / 1024.f) : (1.f / 256.f)) + EPS);
                        float o[8]; unpack8(*(const u32x4*)dst, o);
#pragma unroll
                        for (int e = 0; e < 8; ++e) v[e] = o[e] * rstd * nw[e] * (v[e] * fsigmoid(v[e]));
                    } else {
#pragma unroll
                        for (int e = 0; e < 8; ++e) v[e] = fsigmoid(v[e]);
                    }
                    *(u32x4*)dst = pack8(v);
                }
        }
    }
};
struct EpiC1 {
    static constexpr bool PERM = true;
    bf16_t* P;
    __device__ __forceinline__ void operator()(const f32x4 (&acc)[2][2][4][2], const Unit& u, int wr, int wc, int fr, int fq) const {
        const int br = u.br;
        const int row0 = u.pm * 256 + wr * 64 + fr, colb = u.pn * 256 + wc * 32 + 8 * fq;
#pragma unroll
        for (int bj = 0; bj < 2; ++bj) {
            const int c = colb + bj * 128;
#pragma unroll
            for (int ai = 0; ai < 2; ++ai)
#pragma unroll
                for (int m = 0; m < 4; ++m) {
                    const int row = row0 + ai * 128 + m * 16;
                    float v[8], gt[8];
#pragma unroll
                    for (int e = 0; e < 4; ++e) { v[e] = acc[ai][bj][m][0][e]; v[4 + e] = acc[ai][bj][m][1][e]; }
                    bf16_t* rp = P + (size_t)row * LDP;
                    unpack8(*(const u32x4*)(rp + 1024 + 1024 * br + c), gt);
#pragma unroll
                    for (int e = 0; e < 8; ++e) v[e] *= gt[e];
                    if (br) { float o[8]; unpack8(*(const u32x4*)(rp + 3072 + c), o);
#pragma unroll
                        for (int e = 0; e < 8; ++e) v[e] += o[e]; }
                    *(u32x4*)(rp + 3072 + c) = pack8(v);
                }
        }
    }
};
struct EpiC2a {
    static constexpr bool PERM = true;
    bf16_t* D1; const float* mod;
    __device__ __forceinline__ void operator()(const f32x4 (&acc)[2][2][4][2], const Unit& u, int wr, int wc, int fr, int fq) const {
        const int row0 = u.pm * 256 + wr * 64 + fr, colb = u.pn * 256 + wc * 32 + 8 * fq;
        const float* gp = mod + (u.pm >> 5) * 3072 + 2048;
#pragma unroll
        for (int bj = 0; bj < 2; ++bj) {
            const int c = colb + bj * 128;
            const f32x4 g0 = *(const f32x4*)(gp + c), g1 = *(const f32x4*)(gp + c + 4);
#pragma unroll
            for (int ai = 0; ai < 2; ++ai)
#pragma unroll
                for (int m = 0; m < 4; ++m) {
                    const int row = row0 + ai * 128 + m * 16;
                    float v[8];
#pragma unroll
                    for (int e = 0; e < 4; ++e) { v[e] = acc[ai][bj][m][0][e] * g0[e]; v[4 + e] = acc[ai][bj][m][1][e] * g1[e]; }
                    *(u32x4*)(D1 + (size_t)row * DM + c) = pack8(v);
                }
        }
    }
};
struct EpiC2b {
    static constexpr bool PERM = false;
    const float* x; const bf16_t* D1; float* out; const float* mod;
    __device__ __forceinline__ void operator()(const f32x4 (&acc)[2][2][4][2], const Unit& u, int wr, int wc, int fr, int fq) const {
        const int row0 = u.pm * 256 + wr * 64 + fr, colb = u.pn * 256 + wc * 32 + 4 * fq;
        const float* gp = mod + (u.pm >> 5) * 3072 + 2048;
#pragma unroll
        for (int bj = 0; bj < 2; ++bj)
#pragma unroll
            for (int n = 0; n < 2; ++n) {
                const int c = colb + bj * 128 + n * 16;
                const f32x4 gv = *(const f32x4*)(gp + c);
#pragma unroll
                for (int ai = 0; ai < 2; ++ai)
#pragma unroll
                    for (int m = 0; m < 4; ++m) {
                        const size_t off = (size_t)(row0 + ai * 128 + m * 16) * DM + c;
                        const f32x4 xv = *(const f32x4*)(x + off); const u32x2 d = *(const u32x2*)(D1 + off);
                        f32x4 o = xv + acc[ai][bj][m][n] * gv; o[0] += bf_lo(d.x); o[1] += bf_hi(d.x); o[2] += bf_lo(d.y); o[3] += bf_hi(d.y);
                        *(f32x4*)(out + off) = o;
                    }
            }
    }
};

__device__ __forceinline__ unsigned f2bf(float f) { unsigned u = __float_as_uint(f); return (u + 0x7fffu + ((u >> 16) & 1u)) >> 16; }
__device__ __forceinline__ unsigned pk2(float lo, float hi) { return f2bf(lo) | (f2bf(hi) << 16); }
__device__ __forceinline__ void tr_write(bf16_t* WT, int row_off, int n0, int k0, LAS float* scr, int lane) {
    asm volatile("s_waitcnt lgkmcnt(0)" ::: "memory");
    const int c = lane & 7;
#pragma unroll
    for (int j = 0; j < 4; ++j) { const int n = (lane >> 3) + 8 * j; const LAS float* s = scr + (8 * c) * 33 + n;
        u32x4 o; o.x = pk2(s[0 * 33], s[1 * 33]); o.y = pk2(s[2 * 33], s[3 * 33]); o.z = pk2(s[4 * 33], s[5 * 33]); o.w = pk2(s[6 * 33], s[7 * 33]);
        *(u32x4*)(WT + (size_t)(row_off + n0 + n) * 1024 + k0 + 8 * c) = o; }
    asm volatile("s_waitcnt lgkmcnt(0)" ::: "memory");
}
__device__ __forceinline__ void tr_item(const float* W, int ldw, int col0, bf16_t* WT, int row_off, LAS float* scr, int item, int nblk, int lane) {
    const int kb = item / nblk, nb = item % nblk, k0 = 64 * kb, n0 = 32 * nb;
#pragma unroll 8
    for (int i = 0; i < 32; ++i) { const int kk = 2 * i + (lane >> 5); scr[kk * 33 + (lane & 31)] = W[(size_t)(k0 + kk) * ldw + col0 + n0 + (lane & 31)]; }
    tr_write(WT, row_off, n0, k0, scr, lane);
}
__device__ __forceinline__ void tr_item_la(const float* win, const float* aw, bf16_t* WT, int row_off, LAS float* scr, int item, int lane) {
    const int kb = item / 16, nb = item % 16, k0 = 64 * kb, n0 = 32 * nb;
    float awr[16];
#pragma unroll
    for (int r = 0; r < 16; ++r) awr[r] = aw[r * 512 + n0 + (lane & 31)];
#pragma unroll 4
    for (int i = 0; i < 32; ++i) { const int kk = 2 * i + (lane >> 5); const float* wr_ = win + (size_t)(k0 + kk) * DIN + 7168; float s = 0.f;
#pragma unroll
        for (int r = 0; r < 16; ++r) s += wr_[r] * awr[r];
        scr[kk * 33 + (lane & 31)] = s; }
    tr_write(WT, row_off, n0, k0, scr, lane);
}

constexpr int L_QM = 0, L_KM = 17408, L_QI = 34816;
constexpr int L_KET = 52224, L_VT = 70656;
constexpr int L_ST = 89088, L_PB = 123904;
constexpr int L_PSUM = 133120, L_EBLAST = 137216, L_RED = 137728;
static_assert(L_RED + 2048 <= L_BARST, "LDS map");

template <bool OUT>
__device__ __forceinline__ void la_item(LAS unsigned char* lds, bf16_t* P, float* ST, float* DSC, float* SS, int item, unsigned long long& tacc, unsigned long long& tprev) {
    const int tid = opaque_tid();
    const int lane = tid & 63, w = __builtin_amdgcn_readfirstlane(tid >> 6), fr = lane & 15, fq = lane >> 4;
    const int sc = item & 15, vh = (item >> 4) & 15, b = item >> 8;
    const int row0 = b * SEQ + sc * 512;
    int qcol, kcol, gcol, vcol, sscol;
    if (vh < 8) { qcol = 128 * vh; kcol = -1; gcol = 1024 + 128 * vh; vcol = 2048 + 128 * vh; sscol = 0; }
    else { const int j = (vh - 8) >> 1, e = (vh - 8) & 1; qcol = 3072 + 128 * j; kcol = 3584 + 128 * j; gcol = 5120 + 128 * j; vcol = 4096 + 256 * j + 128 * e; sscol = 1 + j; }
    const int ocol = (vh < 8) ? qcol : vcol;
    float* stp = ST + (size_t)item * 16384;
    f32x4 S[8];
#pragma unroll
    for (int j = 0; j < 8; ++j)
#pragma unroll
        for (int i = 0; i < 4; ++i) S[j][i] = OUT ? stp[(16 * w + 4 * fq + i) * 128 + 16 * j + fr] : 0.f;
#define LA_T(idx) do { if (PROBE_LA && OUT) { const unsigned long long now_ = __builtin_amdgcn_s_memrealtime(); if (PROBE_LA == (idx)) tacc += now_ - tprev; tprev = now_; } } while (0)
#define LA_PUT_ST() do { _Pragma("unroll") for (int j_ = 0; j_ < 8; ++j_) { u32x2 o_; o_.x = cvt_pk_bf16(S[j_][0], S[j_][1]); o_.y = cvt_pk_bf16(S[j_][2], S[j_][3]); \
        *(LAS u32x2*)(lds + L_ST + (16 * j_ + fr) * 272 + (16 * w + 4 * fq) * 2) = o_; } } while (0)
    if (OUT) LA_PUT_ST();
    float btot0 = 0.f, btot1 = 0.f;
    unsigned rgw[8], rvw[8], rkw[8], rqw[8];
    const unsigned lo4 = (unsigned)lane * 4u;
#define LA_ISSUE(c_) do { _Pragma("unroll") for (int j_ = 0; j_ < 8; ++j_) { const char* rp_ = (const char*)(P + (size_t)(row0 + 64 * (c_) + 8 * w + j_) * LDP); \
        rgw[j_] = *(const unsigned*)(rp_ + gcol * 2 + lo4); rvw[j_] = *(const unsigned*)(rp_ + vcol * 2 + lo4); \
        if (kcol >= 0) rkw[j_] = *(const unsigned*)(rp_ + kcol * 2 + lo4); if (OUT) rqw[j_] = *(const unsigned*)(rp_ + qcol * 2 + lo4); } } while (0)
    LA_ISSUE(0);
#pragma unroll 1
    for (int c = 0; c < 8; ++c) {
        LA_T(0);
        {
            float s0 = 0.f, s1 = 0.f;
#pragma unroll
            for (int j = 0; j < 8; ++j) { s0 += bf_lo(rgw[j]); s1 += bf_hi(rgw[j]); }
            *(LAS f32x2*)(lds + L_PSUM + (w * 128 + 2 * lane) * 4) = (f32x2){s0, s1};
        }
        __syncthreads();
        LA_T(1);
        if (OUT && c > 0 && tid < 64) { float tot = 0.f;
#pragma unroll
            for (int ww = 0; ww < 8; ++ww) tot += *(const LAS float*)(lds + L_RED + (ww * 64 + tid) * 4);
            atomicAdd(SS + (size_t)(row0 + 64 * (c - 1) + tid) * 8 + sscol, tot); }
        {
            f32x2 off = (f32x2){0.f, 0.f}, bref = off, bl = off, pw = off;
#pragma unroll
            for (int ww = 0; ww < 8; ++ww) { const f32x2 p = *(const LAS f32x2*)(lds + L_PSUM + (ww * 128 + 2 * lane) * 4);
                if (ww < w) off += p; if (ww == w) pw = p; if (ww < 4) bref += p; bl += p; }
            f32x2 ke[8];
            if (OUT) {
                const f32x2 d0 = off - bref, d1 = bl - bref;
                f32x2 em, im, cb, eb;
                em.x = __builtin_amdgcn_exp2f(d0.x); em.y = __builtin_amdgcn_exp2f(d0.y); im.x = __builtin_amdgcn_exp2f(-d0.x); im.y = __builtin_amdgcn_exp2f(-d0.y);
                cb.x = __builtin_amdgcn_exp2f(d1.x); cb.y = __builtin_amdgcn_exp2f(d1.y); eb.x = __builtin_amdgcn_exp2f(bref.x); eb.y = __builtin_amdgcn_exp2f(bref.y);
#pragma unroll
                for (int j = 0; j < 8; ++j) {
                    const int t = 8 * w + j;
                    const f32x2 g2 = (f32x2){bf_lo(rgw[j]), bf_hi(rgw[j])};
                    f32x2 f2, rf2; f2.x = __builtin_amdgcn_exp2f(g2.x); f2.y = __builtin_amdgcn_exp2f(g2.y); rf2.x = __builtin_amdgcn_rcpf(f2.x); rf2.y = __builtin_amdgcn_rcpf(f2.y);
                    em = em * f2; im = im * rf2;
                    const f32x2 kk = (kcol < 0) ? ((f32x2){1.f, 1.f} - f2) : (f32x2){bf_lo(rkw[j]), bf_hi(rkw[j])};
                    const f32x2 km = kk * im;
                    ke[j] = km * cb;
                    const f32x2 qm = (f32x2){bf_lo(rqw[j]), bf_hi(rqw[j])} * em, qi = qm * eb;
                    *(LAS unsigned*)(lds + L_QM + t * 272 + lane * 4) = cvt_pk_bf16(qm.x, qm.y);
                    *(LAS unsigned*)(lds + L_QI + t * 272 + lane * 4) = cvt_pk_bf16(qi.x, qi.y);
                    *(LAS unsigned*)(lds + L_KM + t * 272 + lane * 4) = cvt_pk_bf16(km.x, km.y);
                }
            } else {
                const f32x2 d = bl - off - pw;
                f32x2 T; T.x = __builtin_amdgcn_exp2f(d.x); T.y = __builtin_amdgcn_exp2f(d.y);
#pragma unroll
                for (int j = 7; j >= 0; --j) {
                    const f32x2 g2 = (f32x2){bf_lo(rgw[j]), bf_hi(rgw[j])};
                    f32x2 f2; f2.x = __builtin_amdgcn_exp2f(g2.x); f2.y = __builtin_amdgcn_exp2f(g2.y);
                    const f32x2 kk = (kcol < 0) ? ((f32x2){1.f, 1.f} - f2) : (f32x2){bf_lo(rkw[j]), bf_hi(rkw[j])};
                    ke[j] = kk * T; T = T * f2;
                }
            }
            u32x4 k0w, k1w, v0w, v1w;
            k0w.x = cvt_pk_bf16(ke[0].x, ke[1].x); k0w.y = cvt_pk_bf16(ke[2].x, ke[3].x); k0w.z = cvt_pk_bf16(ke[4].x, ke[5].x); k0w.w = cvt_pk_bf16(ke[6].x, ke[7].x);
            k1w.x = cvt_pk_bf16(ke[0].y, ke[1].y); k1w.y = cvt_pk_bf16(ke[2].y, ke[3].y); k1w.z = cvt_pk_bf16(ke[4].y, ke[5].y); k1w.w = cvt_pk_bf16(ke[6].y, ke[7].y);
            v0w.x = (rvw[0] & 0xffffu) | (rvw[1] << 16); v0w.y = (rvw[2] & 0xffffu) | (rvw[3] << 16); v0w.z = (rvw[4] & 0xffffu) | (rvw[5] << 16); v0w.w = (rvw[6] & 0xffffu) | (rvw[7] << 16);
            v1w.x = (rvw[0] >> 16) | (rvw[1] & 0xffff0000u); v1w.y = (rvw[2] >> 16) | (rvw[3] & 0xffff0000u); v1w.z = (rvw[4] >> 16) | (rvw[5] & 0xffff0000u); v1w.w = (rvw[6] >> 16) | (rvw[7] & 0xffff0000u);
            *(LAS u32x4*)(lds + L_KET + (2 * lane) * 144 + w * 16) = k0w; *(LAS u32x4*)(lds + L_KET + (2 * lane + 1) * 144 + w * 16) = k1w;
            *(LAS u32x4*)(lds + L_VT + (2 * lane) * 144 + w * 16) = v0w; *(LAS u32x4*)(lds + L_VT + (2 * lane + 1) * 144 + w * 16) = v1w;
            if (w == 0) *(LAS f32x2*)(lds + L_EBLAST + lane * 8) = (f32x2){__builtin_amdgcn_exp2f(bl.x), __builtin_amdgcn_exp2f(bl.y)};
            btot0 += bl.x; btot1 += bl.y;
        }
        if (c < 7) LA_ISSUE(c + 1);
        __syncthreads();
        LA_T(2);
        f32x4 oacc[4];
        if (OUT) {
            {
                const int st = w >> 1, tt0 = (w & 1) * 2;
                bf16x8 xk[4];
#pragma unroll
                for (int kk = 0; kk < 4; ++kk) xk[kk] = *(const LAS bf16x8*)(lds + L_KM + (16 * st + fr) * 272 + (32 * kk + 8 * fq) * 2);
#pragma unroll
                for (int q = 0; q < 2; ++q) {
                    const int tt = tt0 + q;
                    f32x4 a = (f32x4){0.f, 0.f, 0.f, 0.f};
                    if (tt >= st) {
#pragma unroll
                        for (int kk = 0; kk < 4; ++kk) {
                            const bf16x8 yq = *(const LAS bf16x8*)(lds + L_QM + (16 * tt + fr) * 272 + (32 * kk + 8 * fq) * 2);
                            a = __builtin_amdgcn_mfma_f32_16x16x32_bf16(xk[kk], yq, a, 0, 0, 0);
                        }
                    }
                    const int t = 16 * tt + fr, s0 = 16 * st + 4 * fq;
                    u32x2 o; o.x = cvt_pk_bf16(s0 <= t ? a[0] : 0.f, s0 + 1 <= t ? a[1] : 0.f); o.y = cvt_pk_bf16(s0 + 2 <= t ? a[2] : 0.f, s0 + 3 <= t ? a[3] : 0.f);
                    *(LAS u32x2*)(lds + L_PB + t * 144 + s0 * 2) = o;
                }
            }
            {
                bf16x8 xs[4];
#pragma unroll
                for (int kk = 0; kk < 4; ++kk) xs[kk] = *(const LAS bf16x8*)(lds + L_ST + (16 * w + fr) * 272 + (32 * kk + 8 * fq) * 2);
#pragma unroll
                for (int tt = 0; tt < 4; ++tt) {
                    f32x4 a = (f32x4){0.f, 0.f, 0.f, 0.f};
#pragma unroll
                    for (int kk = 0; kk < 4; ++kk) {
                        const bf16x8 yq = *(const LAS bf16x8*)(lds + L_QI + (16 * tt + fr) * 272 + (32 * kk + 8 * fq) * 2);
                        a = __builtin_amdgcn_mfma_f32_16x16x32_bf16(xs[kk], yq, a, 0, 0, 0);
                    }
                    oacc[tt] = a;
                }
            }
            __syncthreads();
            LA_T(3);
            {
                bf16x8 xv[2];
#pragma unroll
                for (int ss = 0; ss < 2; ++ss) xv[ss] = *(const LAS bf16x8*)(lds + L_VT + (16 * w + fr) * 144 + (32 * ss + 8 * fq) * 2);
#pragma unroll
                for (int tt = 0; tt < 4; ++tt) {
                    f32x4 a = oacc[tt];
#pragma unroll
                    for (int ss = 0; ss < 2; ++ss) {
                        const bf16x8 yp = *(const LAS bf16x8*)(lds + L_PB + (16 * tt + fr) * 144 + (32 * ss + 8 * fq) * 2);
                        a = __builtin_amdgcn_mfma_f32_16x16x32_bf16(xv[ss], yp, a, 0, 0, 0);
                    }
                    float q2 = a[0] * a[0] + a[1] * a[1] + a[2] * a[2] + a[3] * a[3];
                    q2 += __shfl_xor(q2, 16); q2 += __shfl_xor(q2, 32);
                    if (fq == 0) *(LAS float*)(lds + L_RED + (w * 64 + 16 * tt + fr) * 4) = q2;
                    u32x2 o; o.x = cvt_pk_bf16(a[0], a[1]); o.y = cvt_pk_bf16(a[2], a[3]);
                    *(u32x2*)(P + (size_t)(row0 + 64 * c + 16 * tt + fr) * LDP + ocol + 16 * w + 4 * fq) = o;
                }
            }
        }
        {
            const f32x4 el = *(const LAS f32x4*)(lds + L_EBLAST + (16 * w + 4 * fq) * 4);
            bf16x8 xk[2];
#pragma unroll
            for (int ss = 0; ss < 2; ++ss) xk[ss] = *(const LAS bf16x8*)(lds + L_KET + (16 * w + fr) * 144 + (32 * ss + 8 * fq) * 2);
#pragma unroll
            for (int j = 0; j < 8; ++j) {
                S[j] = S[j] * el;
#pragma unroll
                for (int ss = 0; ss < 2; ++ss) {
                    const bf16x8 yv = *(const LAS bf16x8*)(lds + L_VT + (16 * j + fr) * 144 + (32 * ss + 8 * fq) * 2);
                    S[j] = __builtin_amdgcn_mfma_f32_16x16x32_bf16(xk[ss], yv, S[j], 0, 0, 0);
                }
            }
        }
        if (OUT && c < 7) LA_PUT_ST();
        LA_T(4);
    }
    if (OUT) {
        __syncthreads();
        if (tid < 64) { float tot = 0.f;
#pragma unroll
            for (int ww = 0; ww < 8; ++ww) tot += *(const LAS float*)(lds + L_RED + (ww * 64 + tid) * 4);
            atomicAdd(SS + (size_t)(row0 + 64 * 7 + tid) * 8 + sscol, tot); }
        __syncthreads();
    } else {
#pragma unroll
        for (int j = 0; j < 8; ++j)
#pragma unroll
            for (int i = 0; i < 4; ++i) stp[(16 * w + 4 * fq + i) * 128 + 16 * j + fr] = S[j][i];
        if (w == 0) *(f32x2*)(DSC + (size_t)item * 128 + 2 * lane) = (f32x2){__builtin_amdgcn_exp2f(btot0), __builtin_amdgcn_exp2f(btot1)};
    }
#undef LA_ISSUE
#undef LA_PUT_ST
}

#define XB_TMO      128
#define XB_XCNT(j)  (256  + 64 * (j))
#define XB_XSUB(j)  (1280 + 64 * (j))
#define XB_XGEN(j)  (2304 + 64 * (j))
#define XB_TOP      3328
#define XB_TOPGEN   3392
#define XCD_BAR_WORDS 3456
#define XB_SPIN_CAP (1u << 18)
__device__ __forceinline__ unsigned xb_ld(unsigned* p)              { return __hip_atomic_load(p, __ATOMIC_RELAXED, __HIP_MEMORY_SCOPE_AGENT); }
__device__ __forceinline__ unsigned xb_add(unsigned* p, unsigned v) { return __hip_atomic_fetch_add(p, v, __ATOMIC_RELAXED, __HIP_MEMORY_SCOPE_AGENT); }
__device__ __forceinline__ unsigned xb_xcc_id() { return (unsigned)__builtin_amdgcn_s_getreg((3 << 11) | 20) & 0xFu; }
#define XB_SPIN(cond, bar) do { unsigned _sp = 0; while (cond) { __builtin_amdgcn_s_sleep(1); \
    if ((++_sp & 255u) == 0u) { if (xb_ld(&(bar)[XB_TMO])) break; if (_sp > XB_SPIN_CAP) { atomicAdd(&(bar)[XB_TMO], 1u); break; } } } } while (0)
struct XcdBarrier { unsigned* bar; unsigned x; volatile LAS unsigned* st; };
__device__ __forceinline__ XcdBarrier xcd_barrier_post(unsigned* bar, volatile LAS unsigned* st) {
    XcdBarrier b; b.bar = bar; b.x = xb_xcc_id(); b.st = st;
    if (threadIdx.x == 0) (void)xb_add(&bar[XB_XCNT(b.x)], 1u);
    return b;
}
__device__ __forceinline__ void xcd_barrier_complete(unsigned* bar, unsigned x, unsigned& nloc, unsigned& nx) {
    const unsigned G = gridDim.x * gridDim.y * gridDim.z;
    unsigned sum, cnt, mine, sp = 0u;
    for (;;) {
        sum = 0u; cnt = 0u; mine = 0u;
#pragma unroll
        for (unsigned j = 0; j < 16; ++j) { const unsigned c = xb_ld(&bar[XB_XCNT(j)]); sum += c; cnt += (c > 0u) ? 1u : 0u; mine = (j == x) ? c : mine; }
        if (sum == G) break;
        __builtin_amdgcn_s_sleep(1);
        if ((++sp & 255u) == 0u) { if (xb_ld(&bar[XB_TMO])) break; if (sp > XB_SPIN_CAP) { atomicAdd(&bar[XB_TMO], 1u); break; } }
    }
    nloc = mine > 0u ? mine : 1u; nx = cnt > 0u ? cnt : 1u;
}
__device__ __forceinline__ void xcd_barrier(const XcdBarrier& b) {
    asm volatile("s_waitcnt vmcnt(0)" ::: "memory");
    __syncthreads();
    if (threadIdx.x == 0) {
        unsigned* bar = b.bar;
        __builtin_amdgcn_s_waitcnt(0);
        unsigned nloc = b.st[0], nx = b.st[1];
        if (nloc == 0u) { xcd_barrier_complete(bar, b.x, nloc, nx); b.st[0] = nloc; b.st[1] = nx; }
        const unsigned old = xb_add(&bar[XB_XSUB(b.x)], 1u);
        const unsigned gen = old / nloc;
        if (old + 1u == (gen + 1u) * nloc) {
            __builtin_amdgcn_fence(__ATOMIC_RELEASE, "agent");
            asm volatile("s_waitcnt vmcnt(0)" ::: "memory");
            const unsigned og = xb_add(&bar[XB_TOP], 1u);
            const unsigned tg = og / nx;
            if (og + 1u == (tg + 1u) * nx) xb_add(&bar[XB_TOPGEN], 1u);
            else XB_SPIN(xb_ld(&bar[XB_TOPGEN]) == tg, bar);
            __builtin_amdgcn_fence(__ATOMIC_ACQUIRE, "agent");
            xb_add(&bar[XB_XGEN(b.x)], 1u);
            asm volatile("s_waitcnt vmcnt(0)" ::: "memory");
        } else {
            XB_SPIN(xb_ld(&bar[XB_XGEN(b.x)]) == gen, bar);
            __builtin_amdgcn_fence(__ATOMIC_ACQUIRE, "agent");
            asm volatile("s_waitcnt vmcnt(0)" ::: "memory");
        }
    }
    __syncthreads();
}

struct Args { const float* x; const float* c; const float* ada_w; const float* ada_b; const float* norm_w; const float* w_in; const float* lb_logits; const float* hnw;
              const float* alpha_w; const float* alpha_b; const float* gnw; const float* w_branch; const float* w_out; const float* fnw; float* out; unsigned char* ws; };

#ifndef PROBE_MASK
#define PROBE_MASK 0
#endif
#ifndef PROBE_LA
#define PROBE_LA 0
#endif
#define PH_END(id) do { if ((id) == 0) { grid.sync(); xbar = xcd_barrier_post((unsigned*)(ws + WS_BAR), (volatile LAS unsigned*)(lds + L_BARST)); } else xcd_barrier(xbar); if (PROBE_MASK) { const unsigned long long now_ = __builtin_amdgcn_s_memrealtime(); if ((PROBE_MASK >> (id)) & 1) tacc += now_ - tprev; tprev = now_; } } while (0)
__global__ void __launch_bounds__(512, 2) fwd_megakernel(Args a) {
    extern __shared__ __attribute__((aligned(16))) unsigned char lds_raw[];
    LAS unsigned char* lds = (LAS unsigned char*)lds_raw;
    cg::grid_group grid = cg::this_grid();
    const int tid = threadIdx.x, lane = tid & 63, wave = __builtin_amdgcn_readfirstlane(tid >> 6);
    const int G = gridDim.x, bid = blockIdx.x;
    const int gw = bid * 8 + wave, NGW = G * 8;
    unsigned char* ws = a.ws;
    XcdBarrier xbar; xbar.bar = nullptr; xbar.x = 0; xbar.st = nullptr;
    if (tid < 2) *(volatile LAS unsigned*)(lds + L_BARST + 4 * tid) = 0u;
    if (bid == 0) for (int i = tid; i < XCD_BAR_WORDS; i += 512) __hip_atomic_store((unsigned*)(ws + WS_BAR) + i, 0u, __ATOMIC_RELAXED, __HIP_MEMORY_SCOPE_AGENT);
    unsigned long long tacc = 0ull, tprev = (PROBE_MASK || PROBE_LA) ? __builtin_amdgcn_s_memrealtime() : 0ull;
    float* mod = (float*)(ws + WS_MOD); float* lbv = (float*)(ws + WS_LB); float* SS = (float*)(ws + WS_SS); float* DSC = (float*)(ws + WS_DSC);
    bf16_t* D1 = (bf16_t*)(ws + WS_D1); bf16_t* P = (bf16_t*)(ws + WS_P);
    bf16_t* H = (bf16_t*)((unsigned char*)a.out + OUT_H); float* ST = (float*)((unsigned char*)a.out + OUT_ST);

    for (int jb = bid; jb < 192; jb += G) {
        LAS float* cact = (LAS float*)lds; LAS float* red = cact + 2048;
        for (int i = tid; i < 2048; i += 512) { const float v = a.c[i]; cact[i] = v * fsigmoid(v); }
        __syncthreads();
        const int l = jb / 96, j0 = (jb % 96) * 32, jj = tid & 31, seg = tid >> 5;
        const float* wp = a.ada_w + (size_t)l * 1024 * 3072 + j0 + jj;
        float a0 = 0.f, a1 = 0.f;
#pragma unroll 8
        for (int i = seg * 64; i < seg * 64 + 64; ++i) { const float wv = wp[(size_t)i * 3072]; a0 += cact[i] * wv; a1 += cact[1024 + i] * wv; }
        red[(seg * 32 + jj) * 2] = a0; red[(seg * 32 + jj) * 2 + 1] = a1;
        __syncthreads();
        if (tid < 64) { const int j2 = tid & 31, b = tid >> 5; float s = 0.f;
#pragma unroll
            for (int sg = 0; sg < 16; ++sg) s += red[(sg * 32 + j2) * 2 + b];
            mod[(l * 2 + b) * 3072 + j0 + j2] = s + a.ada_b[l * 3072 + j0 + j2]; }
        __syncthreads();
    }
    for (int j = bid * 512 + tid; j < 1024; j += G * 512) {
        const float l0 = a.lb_logits[j], l1 = a.lb_logits[1024 + j], mx = fmaxf(l0, l1), e0 = __expf(l0 - mx), e1 = __expf(l1 - mx);
        const float p0 = e0 / (e0 + e1), p1 = e1 / (e0 + e1);
        lbv[j] = 0.f; lbv[1024 + j] = fminf(fmaxf((p0 + p1) - p0, 0.f), 1.f);
    }
    {
        LAS float* scr = (LAS float*)(lds + wave * 8448);
        for (int it = gw; it < 2 * 6400; it += NGW) {
            const int l = it / 6400; int r = it % 6400;
            bf16_t* WT = (bf16_t*)(ws + WS_W + (size_t)l * W_LAYER);
            const float* win = a.w_in + (size_t)l * 1024 * DIN;
            if (r < 1536) { tr_item(win, DIN, 0, WT, 0, scr, r, 96, lane); continue; } r -= 1536;
            if (r < 1024) { tr_item(win, DIN, 4096, WT, 3072, scr, r, 64, lane); continue; } r -= 1024;
            if (r < 256) { tr_item_la(win, a.alpha_w + (size_t)l * 16 * 512, WT, 5120, scr, r, lane); continue; } r -= 256;
            if (r < 512) { tr_item(win, DIN, 3072, WT, 5632, scr, r, 32, lane); continue; } r -= 512;
            if (r < 512) { tr_item(win, DIN, 6144, WT, 6656, scr, r, 32, lane); continue; } r -= 512;
            if (r < 1024) { tr_item(win, DIN, 7184, WT, 7680, scr, r, 64, lane); continue; } r -= 1024;
            if (r < 512) { tr_item(a.w_branch + (size_t)l * 2 * 1048576, 1024, 0, WT, 9728, scr, r, 32, lane); continue; } r -= 512;
            if (r < 512) { tr_item(a.w_branch + (size_t)l * 2 * 1048576 + 1048576, 1024, 0, WT, 10752, scr, r, 32, lane); continue; } r -= 512;
            tr_item(a.w_out + (size_t)l * 1048576, 1024, 0, WT, 11776, scr, r, 32, lane);
        }
    }
    PH_END(0);

#pragma unroll 1
    for (int l = 0; l < 2; ++l) {
        const bf16_t* WT = (const bf16_t*)(ws + WS_W + (size_t)l * W_LAYER);
        const float* modl = mod + l * 2 * 3072;
        { const int tid = opaque_tid(), lane = tid & 63, wave = __builtin_amdgcn_readfirstlane(tid >> 6), gw = bid * 8 + wave;
        for (int i = bid * 512 + tid; i < MROWS * 8; i += G * 512) SS[i] = 0.f;
        for (int m = gw; m < MROWS; m += NGW) {
            const int b = m >> 13;
            const f32x4* xr = (const f32x4*)(a.x + (size_t)m * DM) + lane;
            f32x4 v[4]; float s = 0.f;
#pragma unroll
            for (int j = 0; j < 4; ++j) v[j] = xr[64 * j];
            if (l == 1) { const u32x2* dr = (const u32x2*)(D1 + (size_t)m * DM) + lane;
#pragma unroll
                for (int j = 0; j < 4; ++j) { const u32x2 d = dr[64 * j]; v[j][0] += bf_lo(d.x); v[j][1] += bf_hi(d.x); v[j][2] += bf_lo(d.y); v[j][3] += bf_hi(d.y); } }
#pragma unroll
            for (int j = 0; j < 4; ++j) s += (v[j][0] * v[j][0] + v[j][1] * v[j][1]) + (v[j][2] * v[j][2] + v[j][3] * v[j][3]);
            const float rstd = rsqrtf(wave_sum(s) * (1.f / 1024.f) + EPS);
            const float* mb = modl + b * 3072; const float* nw = a.norm_w + l * 1024;
            u32x2* hr = (u32x2*)(H + (size_t)m * DM) + lane;
#pragma unroll
            for (int j = 0; j < 4; ++j) { const int col = 4 * lane + 256 * j;
                const f32x4 nv = *(const f32x4*)(nw + col), sh = *(const f32x4*)(mb + col), sc = *(const f32x4*)(mb + 1024 + col);
                const f32x4 h = v[j] * rstd * nv * (sc + 1.f) + sh;
                u32x2 o; o.x = cvt_pk_bf16(h[0], h[1]); o.y = cvt_pk_bf16(h[2], h[3]); hr[64 * j] = o; }
        } }
        PH_END(1);
        { pg8::Gemm g{H, WT, 1024, 1024}; pg8::StaticOrder S; S.init(MROWS, 5632, G, bid);
          EpiA1 E{P, lbv + l * 1024, a.alpha_b + l * 512};
          pg8::gemm_phase<EpiA1, pg8::StaticOrder>(lds, g, S, E); }
        PH_END(2);
        for (int item = bid; item < 512; item += G) la_item<false>(lds, P, ST, DSC, SS, item, tacc, tprev);
        PH_END(3);
        for (int gt = bid * 512 + opaque_tid(); gt < 32 * 4096; gt += G * 512) {
            const int chain = gt >> 12, e = gt & 4095, k = e >> 5;
            f32x4* p0 = (f32x4*)(ST + (size_t)chain * 16 * 16384) + e; const float* d0 = DSC + (size_t)chain * 16 * 128 + k;
            f32x4 cur[15]; float dd[15];
#pragma unroll
            for (int sc = 0; sc < 15; ++sc) { cur[sc] = p0[(size_t)sc * 4096]; dd[sc] = d0[sc * 128]; }
            f32x4 carry = (f32x4){0.f, 0.f, 0.f, 0.f};
#pragma unroll
            for (int sc = 0; sc < 16; ++sc) { p0[(size_t)sc * 4096] = carry; if (sc < 15) carry = carry * dd[sc] + cur[sc]; }
        }
        PH_END(4);
        for (int item = bid; item < 512; item += G) la_item<true>(lds, P, ST, DSC, SS, item, tacc, tprev);
        PH_END(5);
        { pg8::Gemm g{H, WT + (size_t)5632 * 1024, 1024, 1024}; pg8::StaticOrder S; S.init(MROWS, 4096, G, bid);
          EpiA2 E{P, SS, a.hnw + l * 1024, a.gnw + l * 256};
          pg8::gemm_phase<EpiA2, pg8::StaticOrder>(lds, g, S, E); }
        PH_END(6);
        { pg8::Gemm g{P, WT + (size_t)9728 * 1024, LDP, 1024}; pg8::BranchOrder S; S.s.init(MROWS, 1024, G, bid);
          EpiC1 E{P};
          pg8::gemm_phase<EpiC1, pg8::BranchOrder>(lds, g, S, E); }
        PH_END(7);
        { pg8::Gemm g{P + 3072, WT + (size_t)11776 * 1024, LDP, 1024}; pg8::StaticOrder S; S.init(MROWS, 1024, G, bid);
          if (l == 0) { EpiC2a E{D1, modl}; pg8::gemm_phase<EpiC2a, pg8::StaticOrder>(lds, g, S, E); }
          else { EpiC2b E{a.x, D1, a.out, modl}; pg8::gemm_phase<EpiC2b, pg8::StaticOrder>(lds, g, S, E); } }
        PH_END(8);
    }
    for (int m = gw; m < MROWS; m += NGW) {
        f32x4* xr = (f32x4*)(a.out + (size_t)m * DM) + lane;
        f32x4 v[4]; float s = 0.f;
#pragma unroll
        for (int j = 0; j < 4; ++j) { v[j] = xr[64 * j]; s += (v[j][0] * v[j][0] + v[j][1] * v[j][1]) + (v[j][2] * v[j][2] + v[j][3] * v[j][3]); }
        const float rstd = rsqrtf(wave_sum(s) * (1.f / 1024.f) + EPS);
#pragma unroll
        for (int j = 0; j < 4; ++j) { const f32x4 nv = *(const f32x4*)(a.fnw + 4 * lane + 256 * j); xr[64 * j] = v[j] * rstd * nv; }
    }
    if (PROBE_MASK || PROBE_LA) { if ((PROBE_MASK >> 9) & 1) tacc += __builtin_amdgcn_s_memrealtime() - tprev;
        if (bid == 0 && threadIdx.x == 0) { const unsigned long long t0 = __builtin_amdgcn_s_memrealtime(); while (__builtin_amdgcn_s_memrealtime() - t0 < 4ull * tacc) __builtin_amdgcn_s_sleep(32); } }
}

extern "C" void kernel_launch(void* const* d_in, const int* in_sizes, int n_in, void* d_out, int out_size, void* d_ws, size_t ws_size, hipStream_t stream) {
    static int grid = 0;
    if (grid == 0) {
        if (n_in != 14 || out_size != MROWS * DM || ws_size < WS_END) { fprintf(stderr, "kernel_launch: unexpected problem (n_in %d, out %d, ws %zu < %zu)\n", n_in, out_size, ws_size, (size_t)WS_END); grid = -1; return; }
        int dev = 0, cus = 0, per_cu = 0;
        if (hipGetDevice(&dev) != hipSuccess || hipDeviceGetAttribute(&cus, hipDeviceAttributeMultiprocessorCount, dev) != hipSuccess) { grid = -1; return; }
        if (hipFuncSetAttribute((const void*)fwd_megakernel, hipFuncAttributeMaxDynamicSharedMemorySize, LDS_BYTES) != hipSuccess) { fprintf(stderr, "kernel_launch: hipFuncSetAttribute failed\n"); grid = -1; return; }
        if (hipOccupancyMaxActiveBlocksPerMultiprocessor(&per_cu, (const void*)fwd_megakernel, 512, LDS_BYTES) != hipSuccess || per_cu < 1) { fprintf(stderr, "kernel_launch: occupancy query says %d\n", per_cu); grid = -1; return; }
        grid = cus;
    }
    if (grid < 0) return;
    Args a{};
    a.x = (const float*)d_in[0]; a.c = (const float*)d_in[1]; a.ada_w = (const float*)d_in[2]; a.ada_b = (const float*)d_in[3]; a.norm_w = (const float*)d_in[4]; a.w_in = (const float*)d_in[5];
    a.lb_logits = (const float*)d_in[6]; a.hnw = (const float*)d_in[7]; a.alpha_w = (const float*)d_in[8]; a.alpha_b = (const float*)d_in[9]; a.gnw = (const float*)d_in[10];
    a.w_branch = (const float*)d_in[11]; a.w_out = (const float*)d_in[12]; a.fnw = (const float*)d_in[13]; a.out = (float*)d_out; a.ws = (unsigned char*)d_ws;
    void* args[] = {&a};
    const hipError_t e = hipLaunchCooperativeKernel((const void*)fwd_megakernel, dim3(grid), dim3(512), args, LDS_BYTES, stream);
    if (e != hipSuccess) fprintf(stderr, "kernel_launch: cooperative launch failed: %s (grid %d)\n", hipGetErrorString(e), grid);
}
```

```cpp
#include <hip/hip_runtime.h>
#include <hip/hip_cooperative_groups.h>
#include <cstdio>
#include <cstdint>
namespace cg = cooperative_groups;
#ifndef PROBE_LA
#define PROBE_LA 0
#endif

#define LAS __attribute__((address_space(3)))
typedef unsigned short bf16_t;
typedef short bf16x8 __attribute__((ext_vector_type(8)));
typedef float f32x4 __attribute__((ext_vector_type(4)));
typedef float f32x2 __attribute__((ext_vector_type(2)));
typedef unsigned u32x4 __attribute__((ext_vector_type(4)));
typedef unsigned u32x2 __attribute__((ext_vector_type(2)));

constexpr int MROWS = 16384, DM = 1024, SEQ = 8192, LDP = 5632, DIN = 9232;
constexpr float EPS = 1e-6f;
constexpr size_t WS_MOD = 4096, WS_LB = 53248, WS_SS = 65536, WS_DSC = 589824, WS_BAR = 860160, WS_W = 1048576, W_LAYER = 26214400;
constexpr size_t WS_D1 = WS_W + 2 * W_LAYER, WS_P = WS_D1 + (size_t)MROWS * DM * 2, WS_END = WS_P + (size_t)MROWS * LDP * 2;
constexpr size_t OUT_H = 0, OUT_ST = 33554432;
constexpr int LDS_BYTES = 147456, L_BARST = 146432;

__device__ __forceinline__ unsigned cvt_pk_bf16(float lo, float hi) { unsigned r; asm volatile("v_cvt_pk_bf16_f32 %0, %1, %2" : "=v"(r) : "v"(lo), "v"(hi)); return r; }
__device__ __forceinline__ float bf_lo(unsigned w) { return __uint_as_float(w << 16); }
__device__ __forceinline__ float bf_hi(unsigned w) { return __uint_as_float(w & 0xffff0000u); }
__device__ __forceinline__ float fsigmoid(float v) { return __builtin_amdgcn_rcpf(1.f + __expf(-v)); }
__device__ __forceinline__ int opaque_tid() { int t = threadIdx.x; asm volatile("" : "+v"(t)); return t; }
__device__ __forceinline__ float wave_sum(float v) {
#pragma unroll
    for (int o = 1; o < 64; o <<= 1) v += __shfl_xor(v, o);
    return v;
}

namespace pg8 {
constexpr int BM = 256, BK = 64, HALF = 128, HTB = HALF * BK * 2, STAGE_BYTES = 8 * HTB, NXCD = 8, WGM = 8;
__host__ __device__ __forceinline__ int lds_byte(int r, int c) { const int st = (r >> 4) * 2 + (c >> 5), rr = r & 15, cc = c & 31, ob = rr * 64 + cc * 2; return st * 1024 + (ob ^ (((ob >> 9) & 1) << 5)); }
__host__ __device__ __forceinline__ void stage_rc(int b, int& R, int& C) { const int st = b / 1024, sb = b % 1024, swz = sb ^ (((sb >> 9) & 1) << 5); R = (st >> 1) * 16 + swz / 64; C = (st & 1) * 32 + (swz % 64) / 2; }
__host__ __device__ __forceinline__ int perm32(int rho) { const int n = rho >> 4, i = rho & 15; return 8 * (i >> 2) + 4 * n + (i & 3); }

struct Unit { int pm, pn, br; unsigned ao, bo; };
struct Gemm { const bf16_t* A; const bf16_t* Bt; int lda, K; };

struct StaticOrder {
    int nM, nN, nwg, G, c;
    __host__ __device__ void init(int M, int N, int G_, int c_) { nM = M / BM; nN = N / BM; nwg = nM * nN; G = G_; c = c_; }
    __host__ __device__ bool next(int i, Unit& u) const {
        const long L = (long)i * G + c; if (L >= nwg) return false;
        int wgid = (int)L; { const int q = nwg / NXCD, r = nwg % NXCD, xcd = wgid % NXCD, off = wgid / NXCD; wgid = (xcd < r ? xcd * (q + 1) : r * (q + 1) + (xcd - r) * q) + off; }
        const int nig = WGM * nN, gid = wgid / nig, fm = gid * WGM, gsz = (nM - fm) < WGM ? (nM - fm) : WGM;
        u.pm = fm + ((wgid % nig) % gsz); u.pn = (wgid % nig) / gsz; u.br = 0; u.ao = 0u; u.bo = 0u; return true;
    }
};
struct BranchOrder {
    StaticOrder s;
    __host__ __device__ bool next(int i, Unit& u) const { if (!s.next(i >> 1, u)) return false; u.br = i & 1; u.ao = (i & 1) ? 4096u * 2u : 0u; u.bo = (i & 1) ? 1024u * 1024u * 2u : 0u; return true; }
};

template <class Epi, class Sched>
__device__ __forceinline__ void gemm_phase(LAS unsigned char* lds, const Gemm g, const Sched& S, const Epi& E) {
    const int tid = opaque_tid(), wid = __builtin_amdgcn_readfirstlane(tid >> 6), lane = tid & 63, wr = wid >> 2, wc = wid & 3, fr = lane & 15, fq = lane >> 4;
    const int K = g.K, nt = K / BK, lda = g.lda;
    unsigned voffA[2], voffB[2];
#pragma unroll
    for (int i = 0; i < 2; ++i) { int R, C; stage_rc(tid * 16 + i * 8192, R, C); const int Rb = Epi::PERM ? ((R & ~31) + perm32(R & 31)) : R;
        voffA[i] = (unsigned)(R * lda + C) * 2u; voffB[i] = (unsigned)(Rb * K + C) * 2u;
        asm volatile("" : "+v"(voffA[i]), "+v"(voffB[i])); }
    const size_t kstep = (size_t)(BK * 2);
    const size_t hA = (size_t)HALF * lda * 2, tA = 2 * hA, hB = (size_t)HALF * K * 2, tB = 2 * hB;
    const unsigned ldsw = (unsigned)wid * 1024u;
    const int aoff = lds_byte(wr * 64 + fr, fq * 8), boff = lds_byte(wc * 32 + fr, fq * 8);
#define PG8_SA(b, h) (((b) * 2 + (h)) * HTB)
#define PG8_SB(b, h) ((4 + (b) * 2 + (h)) * HTB)
#define PG8_STAGE(bufoff, gbase, voff) do { _Pragma("unroll") for (int _i = 0; _i < 2; ++_i) \
        __builtin_amdgcn_global_load_lds((const unsigned*)((const char*)(gbase) + (voff)[_i]), (LAS unsigned*)(lds + (bufoff) + ldsw + _i * 8192), 16, 0, 0); } while (0)
#define PG8_LDA(dst, b, h) do { _Pragma("unroll") for (int m = 0; m < 4; ++m) _Pragma("unroll") for (int k = 0; k < 2; ++k) dst[m][k] = *(const LAS bf16x8*)(lds + PG8_SA(b, h) + aoff + m * 2048 + k * 1024); } while (0)
#define PG8_LDB(dst, b, h) do { _Pragma("unroll") for (int n = 0; n < 2; ++n) _Pragma("unroll") for (int k = 0; k < 2; ++k) dst[n][k] = *(const LAS bf16x8*)(lds + PG8_SB(b, h) + boff + n * 2048 + k * 1024); } while (0)
#define PG8_MMA(ai, bj, At, Bt) do { __builtin_amdgcn_s_setprio(1); _Pragma("unroll") for (int m = 0; m < 4; ++m) _Pragma("unroll") for (int n = 0; n < 2; ++n) _Pragma("unroll") for (int k = 0; k < 2; ++k) \
        acc[ai][bj][m][n] = __builtin_amdgcn_mfma_f32_16x16x32_bf16(Bt[n][k], At[m][k], acc[ai][bj][m][n], 0, 0, 0); __builtin_amdgcn_s_setprio(0); } while (0)
#define PG8_WAIT_V(n) asm volatile("s_waitcnt vmcnt(" #n ")" ::: "memory")
#define PG8_WAIT_L(n) asm volatile("s_waitcnt lgkmcnt(" #n ")" ::: "memory")
#define PG8_BAR __builtin_amdgcn_s_barrier()
#define PG8_SCHED __builtin_amdgcn_sched_barrier(0)
    Unit cur, nxt; int ui = 0;
    if (!S.next(0, cur)) return;
    f32x4 acc[2][2][4][2];
#pragma unroll
    for (int a = 0; a < 2; ++a)
#pragma unroll
        for (int b = 0; b < 2; ++b)
#pragma unroll
            for (int m = 0; m < 4; ++m)
#pragma unroll
                for (int n = 0; n < 2; ++n) acc[a][b][m][n] = (f32x4){0.f, 0.f, 0.f, 0.f};
    bf16x8 At[4][2], B0[2][2], B1[2][2];
    const char* cA = (const char*)g.A + (size_t)cur.pm * tA + cur.ao; const char* cB = (const char*)g.Bt + (size_t)cur.pn * tB + cur.bo;
    PG8_STAGE(PG8_SB(0, 0), cB, voffB); PG8_STAGE(PG8_SB(0, 1), cB + hB, voffB); PG8_STAGE(PG8_SA(0, 0), cA, voffA); PG8_STAGE(PG8_SA(0, 1), cA + hA, voffA);
    if (wr == 1) PG8_BAR;
    PG8_WAIT_V(2); PG8_BAR;
    PG8_STAGE(PG8_SB(1, 0), cB + kstep, voffB); PG8_STAGE(PG8_SA(1, 0), cA + kstep, voffA); PG8_STAGE(PG8_SB(1, 1), cB + hB + kstep, voffB);
    PG8_WAIT_V(6); PG8_BAR;
    for (;;) {
        const bool has_next = S.next(ui + 1, nxt);
        const char* nA = has_next ? (const char*)g.A + (size_t)nxt.pm * tA + nxt.ao : cA; const char* nB = has_next ? (const char*)g.Bt + (size_t)nxt.pn * tB + nxt.bo : cB;
        for (int t = 0; t < nt; t += 2) {
            const bool last = (t == nt - 2);
            const char* a1 = cA + (size_t)(t + 1) * kstep;
            const char* a2 = last ? nA : cA + (size_t)(t + 2) * kstep; const char* b2 = last ? nB : cB + (size_t)(t + 2) * kstep;
            const char* a3 = a2 + kstep; const char* b3 = b2 + kstep;
            PG8_LDB(B0, 0, 0); PG8_LDB(B1, 0, 1); PG8_SCHED; PG8_LDA(At, 0, 0); PG8_STAGE(PG8_SA(1, 1), a1 + hA, voffA);
            PG8_WAIT_V(8); PG8_WAIT_L(0); PG8_BAR; PG8_MMA(0, 0, At, B0); PG8_MMA(0, 1, At, B1); PG8_BAR; PG8_SCHED;
            PG8_LDA(At, 0, 1); PG8_STAGE(PG8_SB(0, 0), b2, voffB); PG8_STAGE(PG8_SB(0, 1), b2 + hB, voffB); PG8_STAGE(PG8_SA(0, 0), a2, voffA);
            PG8_WAIT_V(8); PG8_WAIT_L(0); PG8_BAR; PG8_MMA(1, 0, At, B0); PG8_MMA(1, 1, At, B1); PG8_BAR; PG8_SCHED;
            PG8_LDB(B0, 1, 0); PG8_LDB(B1, 1, 1); PG8_SCHED; PG8_LDA(At, 1, 0); PG8_STAGE(PG8_SA(0, 1), a2 + hA, voffA);
            PG8_WAIT_V(8); PG8_WAIT_L(0); PG8_BAR; PG8_MMA(0, 0, At, B0); PG8_MMA(0, 1, At, B1); PG8_BAR; PG8_SCHED;
            PG8_LDA(At, 1, 1); PG8_STAGE(PG8_SB(1, 0), b3, voffB); PG8_STAGE(PG8_SB(1, 1), b3 + hB, voffB); PG8_STAGE(PG8_SA(1, 0), a3, voffA);
            PG8_WAIT_V(8); PG8_WAIT_L(0); PG8_BAR; PG8_MMA(1, 0, At, B0); PG8_MMA(1, 1, At, B1); PG8_BAR; PG8_SCHED;
        }
        if (wr == 0) PG8_BAR;
        E(acc, cur, wr, wc, fr, fq);
        if (!has_next) break;
#pragma unroll
        for (int a = 0; a < 2; ++a)
#pragma unroll
            for (int b = 0; b < 2; ++b)
#pragma unroll
                for (int m = 0; m < 4; ++m)
#pragma unroll
                    for (int n = 0; n < 2; ++n) acc[a][b][m][n] = (f32x4){0.f, 0.f, 0.f, 0.f};
        cur = nxt; cA = nA; cB = nB; ++ui;
        if (wr == 1) PG8_BAR;
    }
    PG8_WAIT_V(0);
    PG8_BAR;
#undef PG8_SA
#undef PG8_SB
#undef PG8_STAGE
#undef PG8_LDA
#undef PG8_LDB
#undef PG8_MMA
#undef PG8_WAIT_V
#undef PG8_WAIT_L
#undef PG8_BAR
#undef PG8_SCHED
}
}
using pg8::Unit;

__device__ __forceinline__ void unpack8(const u32x4 w, float (&o)[8]) { o[0] = bf_lo(w.x); o[1] = bf_hi(w.x); o[2] = bf_lo(w.y); o[3] = bf_hi(w.y); o[4] = bf_lo(w.z); o[5] = bf_hi(w.z); o[6] = bf_lo(w.w); o[7] = bf_hi(w.w); }
__device__ __forceinline__ u32x4 pack8(const float (&v)[8]) { u32x4 w; w.x = cvt_pk_bf16(v[0], v[1]); w.y = cvt_pk_bf16(v[2], v[3]); w.z = cvt_pk_bf16(v[4], v[5]); w.w = cvt_pk_bf16(v[6], v[7]); return w; }

struct EpiA1 {
    static constexpr bool PERM = true;
    bf16_t* P; const float* lb; const float* ab;
    __device__ __forceinline__ void operator()(const f32x4 (&acc)[2][2][4][2], const Unit& u, int wr, int wc, int fr, int fq) const {
        const int pn = u.pn;
        const int type = pn < 4 ? 0 : pn < 8 ? 1 : pn < 12 ? 2 : pn < 14 ? 3 : pn < 20 ? 2 : 4;
        const int row0 = u.pm * 256 + wr * 64 + fr, colb = pn * 256 + wc * 32 + 8 * fq;
#pragma unroll
        for (int bj = 0; bj < 2; ++bj) {
            const int col = colb + bj * 128;
            float pr[8];
#pragma unroll
            for (int e = 0; e < 8; ++e) pr[e] = 0.f;
            if (type == 1) { const f32x4 p0 = *(const f32x4*)(lb + col - 1024), p1 = *(const f32x4*)(lb + col - 1024 + 4); pr[0] = p0[0]; pr[1] = p0[1]; pr[2] = p0[2]; pr[3] = p0[3]; pr[4] = p1[0]; pr[5] = p1[1]; pr[6] = p1[2]; pr[7] = p1[3]; }
            if (type == 4) { const f32x4 p0 = *(const f32x4*)(ab + col - 5120), p1 = *(const f32x4*)(ab + col - 5120 + 4); pr[0] = p0[0]; pr[1] = p0[1]; pr[2] = p0[2]; pr[3] = p0[3]; pr[4] = p1[0]; pr[5] = p1[1]; pr[6] = p1[2]; pr[7] = p1[3]; }
#pragma unroll
            for (int ai = 0; ai < 2; ++ai)
#pragma unroll
                for (int m = 0; m < 4; ++m) {
                    const int row = row0 + ai * 128 + m * 16;
                    float v[8];
#pragma unroll
                    for (int e = 0; e < 4; ++e) { v[e] = acc[ai][bj][m][0][e]; v[4 + e] = acc[ai][bj][m][1][e]; }
                    if (type == 0) {
#pragma unroll
                        for (int e = 0; e < 8; ++e) v[e] = v[e] * fsigmoid(v[e]);
                    } else if (type == 1) {
#pragma unroll
                        for (int e = 0; e < 8; ++e) { const float f = pr[e] + (1.f - pr[e]) * fsigmoid(v[e]); v[e] = __log2f(fmaxf(f, 1e-20f)); }
                    } else if (type == 3) {
#pragma unroll
                        for (int e = 0; e < 8; ++e) v[e] *= 0.08838834764831845f;
                    } else if (type == 4) {
#pragma unroll
                        for (int e = 0; e < 8; ++e) { const float z = v[e] + pr[e]; v[e] = (fminf(z, 0.f) - __logf(1.f + __expf(-fabsf(z)))) * (0.0625f * 1.4426950408889634f); }
                    }
                    *(u32x4*)(P + (size_t)row * LDP + col) = pack8(v);
                }
        }
    }
};
struct EpiA2 {
    static constexpr bool PERM = true;
    bf16_t* P; const float* SS; const float* hnw; const float* gnw;
    __device__ __forceinline__ void operator()(const f32x4 (&acc)[2][2][4][2], const Unit& u, int wr, int wc, int fr, int fq) const {
        const int pn = u.pn;
        const int row0 = u.pm * 256 + wr * 64 + fr, cw = wc * 32 + 8 * fq;
#pragma unroll
        for (int bj = 0; bj < 2; ++bj) {
            const int cin = cw + bj * 128;
            float nw[8];
#pragma unroll
            for (int e = 0; e < 8; ++e) nw[e] = 1.f;
            int dcol;
            if (pn < 4) { dcol = pn * 256 + cin; const f32x4 p0 = *(const f32x4*)(hnw + dcol), p1 = *(const f32x4*)(hnw + dcol + 4); nw[0] = p0[0]; nw[1] = p0[1]; nw[2] = p0[2]; nw[3] = p0[3]; nw[4] = p1[0]; nw[5] = p1[1]; nw[6] = p1[2]; nw[7] = p1[3]; }
            else if (pn < 8) { dcol = 4096 + (pn - 4) * 256 + cin; const f32x4 p0 = *(const f32x4*)(gnw + cin), p1 = *(const f32x4*)(gnw + cin + 4); nw[0] = p0[0]; nw[1] = p0[1]; nw[2] = p0[2]; nw[3] = p0[3]; nw[4] = p1[0]; nw[5] = p1[1]; nw[6] = p1[2]; nw[7] = p1[3]; }
            else dcol = 1024 + (pn - 8) * 256 + cin;
#pragma unroll
            for (int ai = 0; ai < 2; ++ai)
#pragma unroll
                for (int m = 0; m < 4; ++m) {
                    const int row = row0 + ai * 128 + m * 16;
                    float v[8];
#pragma unroll
                    for (int e = 0; e < 4; ++e) { v[e] = acc[ai][bj][m][0][e]; v[4 + e] = acc[ai][bj][m][1][e]; }
                    bf16_t* dst = P + (size_t)row * LDP + dcol;
                    if (pn < 8) {
                        const float ssv = (pn < 4) ? SS[row * 8] : SS[row * 8 + 1 + (pn - 4)];
                        const float rstd = rsqrtf(ssv * ((pn < 4) ? (1.f / 1024.f) : (1.f / 256.f)) + EPS);
                        float o[8]; unpack8(*(const u32x4*)dst, o);
#pragma unroll
                        for (int e = 0; e < 8; ++e) v[e] = o[e] * rstd * nw[e] * (v[e] * fsigmoid(v[e]));
                    } else {
#pragma unroll
                        for (int e = 0; e < 8; ++e) v[e] = fsigmoid(v[e]);
                    }
                    *(u32x4*)dst = pack8(v);
                }
        }
    }
};
struct EpiC1 {
    static constexpr bool PERM = true;
    bf16_t* P;
    __device__ __forceinline__ void operator()(const f32x4 (&acc)[2][2][4][2], const Unit& u, int wr, int wc, int fr, int fq) const {
        const int br = u.br;
        const int row0 = u.pm * 256 + wr * 64 + fr, colb = u.pn * 256 + wc * 32 + 8 * fq;
#pragma unroll
        for (int bj = 0; bj < 2; ++bj) {
            const int c = colb + bj * 128;
#pragma unroll
            for (int ai = 0; ai < 2; ++ai)
#pragma unroll
                for (int m = 0; m < 4; ++m) {
                    const int row = row0 + ai * 128 + m * 16;
                    float v[8], gt[8];
#pragma unroll
                    for (int e = 0; e < 4; ++e) { v[e] = acc[ai][bj][m][0][e]; v[4 + e] = acc[ai][bj][m][1][e]; }
                    bf16_t* rp = P + (size_t)row * LDP;
                    unpack8(*(const u32x4*)(rp + 1024 + 1024 * br + c), gt);
#pragma unroll
                    for (int e = 0; e < 8; ++e) v[e] *= gt[e];
                    if (br) { float o[8]; unpack8(*(const u32x4*)(rp + 3072 + c), o);
#pragma unroll
                        for (int e = 0; e < 8; ++e) v[e] += o[e]; }
                    *(u32x4*)(rp + 3072 + c) = pack8(v);
                }
        }
    }
};
struct EpiC2a {
    static constexpr bool PERM = true;
    bf16_t* D1; const float* mod;
    __device__ __forceinline__ void operator()(const f32x4 (&acc)[2][2][4][2], const Unit& u, int wr, int wc, int fr, int fq) const {
        const int row0 = u.pm * 256 + wr * 64 + fr, colb = u.pn * 256 + wc * 32 + 8 * fq;
        const float* gp = mod + (u.pm >> 5) * 3072 + 2048;
#pragma unroll
        for (int bj = 0; bj < 2; ++bj) {
            const int c = colb + bj * 128;
            const f32x4 g0 = *(const f32x4*)(gp + c), g1 = *(const f32x4*)(gp + c + 4);
#pragma unroll
            for (int ai = 0; ai < 2; ++ai)
#pragma unroll
                for (int m = 0; m < 4; ++m) {
                    const int row = row0 + ai * 128 + m * 16;
                    float v[8];
#pragma unroll
                    for (int e = 0; e < 4; ++e) { v[e] = acc[ai][bj][m][0][e] * g0[e]; v[4 + e] = acc[ai][bj][m][1][e] * g1[e]; }
                    *(u32x4*)(D1 + (size_t)row * DM + c) = pack8(v);
                }
        }
    }
};
struct EpiC2b {
    static constexpr bool PERM = false;
    const float* x; const bf16_t* D1; float* out; const float* mod;
    __device__ __forceinline__ void operator()(const f32x4 (&acc)[2][2][4][2], const Unit& u, int wr, int wc, int fr, int fq) const {
        const int row0 = u.pm * 256 + wr * 64 + fr, colb = u.pn * 256 + wc * 32 + 4 * fq;
        const float* gp = mod + (u.pm >> 5) * 3072 + 2048;
#pragma unroll
        for (int bj = 0; bj < 2; ++bj)
#pragma unroll
            for (int n = 0; n < 2; ++n) {
                const int c = colb + bj * 128 + n * 16;
                const f32x4 gv = *(const f32x4*)(gp + c);
#pragma unroll
                for (int ai = 0; ai < 2; ++ai)
#pragma unroll
                    for (int m = 0; m < 4; ++m) {
                        const size_t off = (size_t)(row0 + ai * 128 + m * 16) * DM + c;
                        const f32x4 xv = *(const f32x4*)(x + off); const u32x2 d = *(const u32x2*)(D1 + off);
                        f32x4 o = xv + acc[ai][bj][m][n] * gv; o[0] += bf_lo(d.x); o[1] += bf_hi(d.x); o[2] += bf_lo(d.y); o[3] += bf_hi(d.y);
                        *(f32x4*)(out + off) = o;
                    }
            }
    }
};

__device__ __forceinline__ unsigned f2bf(float f) { unsigned u = __float_as_uint(f); return (u + 0x7fffu + ((u >> 16) & 1u)) >> 16; }
__device__ __forceinline__ unsigned pk2(float lo, float hi) { return f2bf(lo) | (f2bf(hi) << 16); }
__device__ __forceinline__ void tr_write(bf16_t* WT, int row_off, int n0, int k0, LAS float* scr, int lane) {
    asm volatile("s_waitcnt lgkmcnt(0)" ::: "memory");
    const int c = lane & 7;
#pragma unroll
    for (int j = 0; j < 4; ++j) { const int n = (lane >> 3) + 8 * j; const LAS float* s = scr + (8 * c) * 33 + n;
        u32x4 o; o.x = pk2(s[0 * 33], s[1 * 33]); o.y = pk2(s[2 * 33], s[3 * 33]); o.z = pk2(s[4 * 33], s[5 * 33]); o.w = pk2(s[6 * 33], s[7 * 33]);
        *(u32x4*)(WT + (size_t)(row_off + n0 + n) * 1024 + k0 + 8 * c) = o; }
    asm volatile("s_waitcnt lgkmcnt(0)" ::: "memory");
}
__device__ __forceinline__ void tr_item(const float* W, int ldw, int col0, bf16_t* WT, int row_off, LAS float* scr, int item, int nblk, int lane) {
    const int kb = item / nblk, nb = item % nblk, k0 = 64 * kb, n0 = 32 * nb;
#pragma unroll 8
    for (int i = 0; i < 32; ++i) { const int kk = 2 * i + (lane >> 5); scr[kk * 33 + (lane & 31)] = W[(size_t)(k0 + kk) * ldw + col0 + n0 + (lane & 31)]; }
    tr_write(WT, row_off, n0, k0, scr, lane);
}
__device__ __forceinline__ void tr_item_la(const float* win, const float* aw, bf16_t* WT, int row_off, LAS float* scr, int item, int lane) {
    const int kb = item / 16, nb = item % 16, k0 = 64 * kb, n0 = 32 * nb;
    float awr[16];
#pragma unroll
    for (int r = 0; r < 16; ++r) awr[r] = aw[r * 512 + n0 + (lane & 31)];
#pragma unroll 4
    for (int i = 0; i < 32; ++i) { const int kk = 2 * i + (lane >> 5); const float* wr_ = win + (size_t)(k0 + kk) * DIN + 7168; float s = 0.f;
#pragma unroll
        for (int r = 0; r < 16; ++r) s += wr_[r] * awr[r];
        scr[kk * 33 + (lane & 31)] = s; }
    tr_write(WT, row_off, n0, k0, scr, lane);
}

constexpr int L_QM = 0, L_KM = 17408, L_QI = 34816;
constexpr int L_KET = 52224, L_VT = 70656;
constexpr int L_ST = 89088, L_PB = 123904;
constexpr int L_PSUM = 133120, L_EBLAST = 137216, L_RED = 137728;
static_assert(L_RED + 2048 <= L_BARST, "LDS map");

template <bool OUT>
__device__ __forceinline__ void la_item(LAS unsigned char* lds, bf16_t* P, float* ST, float* DSC, float* SS, int item, unsigned long long& tacc, unsigned long long& tprev) {
    const int tid = opaque_tid();
    const int lane = tid & 63, w = __builtin_amdgcn_readfirstlane(tid >> 6), fr = lane & 15, fq = lane >> 4;
    const int sc = item & 15, vh = (item >> 4) & 15, b = item >> 8;
    const int row0 = b * SEQ + sc * 512;
    int qcol, kcol, gcol, vcol, sscol;
    if (vh < 8) { qcol = 128 * vh; kcol = -1; gcol = 1024 + 128 * vh; vcol = 2048 + 128 * vh; sscol = 0; }
    else { const int j = (vh - 8) >> 1, e = (vh - 8) & 1; qcol = 3072 + 128 * j; kcol = 3584 + 128 * j; gcol = 5120 + 128 * j; vcol = 4096 + 256 * j + 128 * e; sscol = 1 + j; }
    const int ocol = (vh < 8) ? qcol : vcol;
    float* stp = ST + (size_t)item * 16384;
    f32x4 S[8];
#pragma unroll
    for (int j = 0; j < 8; ++j)
#pragma unroll
        for (int i = 0; i < 4; ++i) S[j][i] = OUT ? stp[(16 * w + 4 * fq + i) * 128 + 16 * j + fr] : 0.f;
#define LA_T(idx) do { if (PROBE_LA && OUT) { const unsigned long long now_ = __builtin_amdgcn_s_memrealtime(); if (PROBE_LA == (idx)) tacc += now_ - tprev; tprev = now_; } } while (0)
#define LA_PUT_ST() do { _Pragma("unroll") for (int j_ = 0; j_ < 8; ++j_) { u32x2 o_; o_.x = cvt_pk_bf16(S[j_][0], S[j_][1]); o_.y = cvt_pk_bf16(S[j_][2], S[j_][3]); \
        *(LAS u32x2*)(lds + L_ST + (16 * j_ + fr) * 272 + (16 * w + 4 * fq) * 2) = o_; } } while (0)
    if (OUT) LA_PUT_ST();
    float btot0 = 0.f, btot1 = 0.f;
    unsigned rgw[8], rvw[8], rkw[8], rqw[8];
    const unsigned lo4 = (unsigned)lane * 4u;
#define LA_ISSUE(c_) do { _Pragma("unroll") for (int j_ = 0; j_ < 8; ++j_) { const char* rp_ = (const char*)(P + (size_t)(row0 + 64 * (c_) + 8 * w + j_) * LDP); \
        rgw[j_] = *(const unsigned*)(rp_ + gcol * 2 + lo4); rvw[j_] = *(const unsigned*)(rp_ + vcol * 2 + lo4); \
        if (kcol >= 0) rkw[j_] = *(const unsigned*)(rp_ + kcol * 2 + lo4); if (OUT) rqw[j_] = *(const unsigned*)(rp_ + qcol * 2 + lo4); } } while (0)
    LA_ISSUE(0);
#pragma unroll 1
    for (int c = 0; c < 8; ++c) {
        LA_T(0);
        {
            float s0 = 0.f, s1 = 0.f;
#pragma unroll
            for (int j = 0; j < 8; ++j) { s0 += bf_lo(rgw[j]); s1 += bf_hi(rgw[j]); }
            *(LAS f32x2*)(lds + L_PSUM + (w * 128 + 2 * lane) * 4) = (f32x2){s0, s1};
        }
        __syncthreads();
        LA_T(1);
        if (OUT && c > 0 && tid < 64) { float tot = 0.f;
#pragma unroll
            for (int ww = 0; ww < 8; ++ww) tot += *(const LAS float*)(lds + L_RED + (ww * 64 + tid) * 4);
            atomicAdd(SS + (size_t)(row0 + 64 * (c - 1) + tid) * 8 + sscol, tot); }
        {
            f32x2 off = (f32x2){0.f, 0.f}, bref = off, bl = off, pw = off;
#pragma unroll
            for (int ww = 0; ww < 8; ++ww) { const f32x2 p = *(const LAS f32x2*)(lds + L_PSUM + (ww * 128 + 2 * lane) * 4);
                if (ww < w) off += p; if (ww == w) pw = p; if (ww < 4) bref += p; bl += p; }
            f32x2 ke[8];
            if (OUT) {
                const f32x2 d0 = off - bref, d1 = bl - bref;
                f32x2 em, im, cb, eb;
                em.x = __builtin_amdgcn_exp2f(d0.x); em.y = __builtin_amdgcn_exp2f(d0.y); im.x = __builtin_amdgcn_exp2f(-d0.x); im.y = __builtin_amdgcn_exp2f(-d0.y);
                cb.x = __builtin_amdgcn_exp2f(d1.x); cb.y = __builtin_amdgcn_exp2f(d1.y); eb.x = __builtin_amdgcn_exp2f(bref.x); eb.y = __builtin_amdgcn_exp2f(bref.y);
#pragma unroll
                for (int j = 0; j < 8; ++j) {
                    const int t = 8 * w + j;
                    const f32x2 g2 = (f32x2){bf_lo(rgw[j]), bf_hi(rgw[j])};
                    f32x2 f2, rf2; f2.x = __builtin_amdgcn_exp2f(g2.x); f2.y = __builtin_amdgcn_exp2f(g2.y); rf2.x = __builtin_amdgcn_rcpf(f2.x); rf2.y = __builtin_amdgcn_rcpf(f2.y);
                    em = em * f2; im = im * rf2;
                    const f32x2 kk = (kcol < 0) ? ((f32x2){1.f, 1.f} - f2) : (f32x2){bf_lo(rkw[j]), bf_hi(rkw[j])};
                    const f32x2 km = kk * im;
                    ke[j] = km * cb;
                    const f32x2 qm = (f32x2){bf_lo(rqw[j]), bf_hi(rqw[j])} * em, qi = qm * eb;
                    *(LAS unsigned*)(lds + L_QM + t * 272 + lane * 4) = cvt_pk_bf16(qm.x, qm.y);
                    *(LAS unsigned*)(lds + L_QI + t * 272 + lane * 4) = cvt_pk_bf16(qi.x, qi.y);
                    *(LAS unsigned*)(lds + L_KM + t * 272 + lane * 4) = cvt_pk_bf16(km.x, km.y);
                }
            } else {
                const f32x2 d = bl - off - pw;
                f32x2 T; T.x = __builtin_amdgcn_exp2f(d.x); T.y = __builtin_amdgcn_exp2f(d.y);
#pragma unroll
                for (int j = 7; j >= 0; --j) {
                    const f32x2 g2 = (f32x2){bf_lo(rgw[j]), bf_hi(rgw[j])};
                    f32x2 f2; f2.x = __builtin_amdgcn_exp2f(g2.x); f2.y = __builtin_amdgcn_exp2f(g2.y);
                    const f32x2 kk = (kcol < 0) ? ((f32x2){1.f, 1.f} - f2) : (f32x2){bf_lo(rkw[j]), bf_hi(rkw[j])};
                    ke[j] = kk * T; T = T * f2;
                }
            }
            u32x4 k0w, k1w, v0w, v1w;
            k0w.x = cvt_pk_bf16(ke[0].x, ke[1].x); k0w.y = cvt_pk_bf16(ke[2].x, ke[3].x); k0w.z = cvt_pk_bf16(ke[4].x, ke[5].x); k0w.w = cvt_pk_bf16(ke[6].x, ke[7].x);
            k1w.x = cvt_pk_bf16(ke[0].y, ke[1].y); k1w.y = cvt_pk_bf16(ke[2].y, ke[3].y); k1w.z = cvt_pk_bf16(ke[4].y, ke[5].y); k1w.w = cvt_pk_bf16(ke[6].y, ke[7].y);
            v0w.x = (rvw[0] & 0xffffu) | (rvw[1] << 16); v0w.y = (rvw[2] & 0xffffu) | (rvw[3] << 16); v0w.z = (rvw[4] & 0xffffu) | (rvw[5] << 16); v0w.w = (rvw[6] & 0xffffu) | (rvw[7] << 16);
            v1w.x = (rvw[0] >> 16) | (rvw[1] & 0xffff0000u); v1w.y = (rvw[2] >> 16) | (rvw[3] & 0xffff0000u); v1w.z = (rvw[4] >> 16) | (rvw[5] & 0xffff0000u); v1w.w = (rvw[6] >> 16) | (rvw[7] & 0xffff0000u);
            *(LAS u32x4*)(lds + L_KET + (2 * lane) * 144 + w * 16) = k0w; *(LAS u32x4*)(lds + L_KET + (2 * lane + 1) * 144 + w * 16) = k1w;
            *(LAS u32x4*)(lds + L_VT + (2 * lane) * 144 + w * 16) = v0w; *(LAS u32x4*)(lds + L_VT + (2 * lane + 1) * 144 + w * 16) = v1w;
            if (w == 0) *(LAS f32x2*)(lds + L_EBLAST + lane * 8) = (f32x2){__builtin_amdgcn_exp2f(bl.x), __builtin_amdgcn_exp2f(bl.y)};
            btot0 += bl.x; btot1 += bl.y;
        }
        if (c < 7) LA_ISSUE(c + 1);
        __syncthreads();
        LA_T(2);
        f32x4 oacc[4];
        if (OUT) {
            {
                const int st = w >> 1, tt0 = (w & 1) * 2;
                bf16x8 xk[4];
#pragma unroll
                for (int kk = 0; kk < 4; ++kk) xk[kk] = *(const LAS bf16x8*)(lds + L_KM + (16 * st + fr) * 272 + (32 * kk + 8 * fq) * 2);
#pragma unroll
                for (int q = 0; q < 2; ++q) {
                    const int tt = tt0 + q;
                    f32x4 a = (f32x4){0.f, 0.f, 0.f, 0.f};
                    if (tt >= st) {
#pragma unroll
                        for (int kk = 0; kk < 4; ++kk) {
                            const bf16x8 yq = *(const LAS bf16x8*)(lds + L_QM + (16 * tt + fr) * 272 + (32 * kk + 8 * fq) * 2);
                            a = __builtin_amdgcn_mfma_f32_16x16x32_bf16(xk[kk], yq, a, 0, 0, 0);
                        }
                    }
                    const int t = 16 * tt + fr, s0 = 16 * st + 4 * fq;
                    u32x2 o; o.x = cvt_pk_bf16(s0 <= t ? a[0] : 0.f, s0 + 1 <= t ? a[1] : 0.f); o.y = cvt_pk_bf16(s0 + 2 <= t ? a[2] : 0.f, s0 + 3 <= t ? a[3] : 0.f);
                    *(LAS u32x2*)(lds + L_PB + t * 144 + s0 * 2) = o;
                }
            }
            {
                bf16x8 xs[4];
#pragma unroll
                for (int kk = 0; kk < 4; ++kk) xs[kk] = *(const LAS bf16x8*)(lds + L_ST + (16 * w + fr) * 272 + (32 * kk + 8 * fq) * 2);
#pragma unroll
                for (int tt = 0; tt < 4; ++tt) {
                    f32x4 a = (f32x4){0.f, 0.f, 0.f, 0.f};
#pragma unroll
                    for (int kk = 0; kk < 4; ++kk) {
                        const bf16x8 yq = *(const LAS bf16x8*)(lds + L_QI + (16 * tt + fr) * 272 + (32 * kk + 8 * fq) * 2);
                        a = __builtin_amdgcn_mfma_f32_16x16x32_bf16(xs[kk], yq, a, 0, 0, 0);
                    }
                    oacc[tt] = a;
                }
            }
            __syncthreads();
            LA_T(3);
            {
                bf16x8 xv[2];
#pragma unroll
                for (int ss = 0; ss < 2; ++ss) xv[ss] = *(const LAS bf16x8*)(lds + L_VT + (16 * w + fr) * 144 + (32 * ss + 8 * fq) * 2);
#pragma unroll
                for (int tt = 0; tt < 4; ++tt) {
                    f32x4 a = oacc[tt];
#pragma unroll
                    for (int ss = 0; ss < 2; ++ss) {
                        const bf16x8 yp = *(const LAS bf16x8*)(lds + L_PB + (16 * tt + fr) * 144 + (32 * ss + 8 * fq) * 2);
                        a = __builtin_amdgcn_mfma_f32_16x16x32_bf16(xv[ss], yp, a, 0, 0, 0);
                    }
                    float q2 = a[0] * a[0] + a[1] * a[1] + a[2] * a[2] + a[3] * a[3];
                    q2 += __shfl_xor(q2, 16); q2 += __shfl_xor(q2, 32);
                    if (fq == 0) *(LAS float*)(lds + L_RED + (w * 64 + 16 * tt + fr) * 4) = q2;
                    u32x2 o; o.x = cvt_pk_bf16(a[0], a[1]); o.y = cvt_pk_bf16(a[2], a[3]);
                    *(u32x2*)(P + (size_t)(row0 + 64 * c + 16 * tt + fr) * LDP + ocol + 16 * w + 4 * fq) = o;
                }
            }
        }
        {
            const f32x4 el = *(const LAS f32x4*)(lds + L_EBLAST + (16 * w + 4 * fq) * 4);
            bf16x8 xk[2];
#pragma unroll
            for (int ss = 0; ss < 2; ++ss) xk[ss] = *(const LAS bf16x8*)(lds + L_KET + (16 * w + fr) * 144 + (32 * ss + 8 * fq) * 2);
#pragma unroll
            for (int j = 0; j < 8; ++j) {
                S[j] = S[j] * el;
#pragma unroll
                for (int ss = 0; ss < 2; ++ss) {
                    const bf16x8 yv = *(const LAS bf16x8*)(lds + L_VT + (16 * j + fr) * 144 + (32 * ss + 8 * fq) * 2);
                    S[j] = __builtin_amdgcn_mfma_f32_16x16x32_bf16(xk[ss], yv, S[j], 0, 0, 0);
                }
            }
        }
        if (OUT && c < 7) LA_PUT_ST();
        LA_T(4);
    }
    if (OUT) {
        __syncthreads();
        if (tid < 64) { float tot = 0.f;
#pragma unroll
            for (int ww = 0; ww < 8; ++ww) tot += *(const LAS float*)(lds + L_RED + (ww * 64 + tid) * 4);
            atomicAdd(SS + (size_t)(row0 + 64 * 7 + tid) * 8 + sscol, tot); }
        __syncthreads();
    } else {
#pragma unroll
        for (int j = 0; j < 8; ++j)
#pragma unroll
            for (int i = 0; i < 4; ++i) stp[(16 * w + 4 * fq + i) * 128 + 16 * j + fr] = S[j][i];
        if (w == 0) *(f32x2*)(DSC + (size_t)item * 128 + 2 * lane) = (f32x2){__builtin_amdgcn_exp2f(btot0), __builtin_amdgcn_exp2f(btot1)};
    }
#undef LA_ISSUE
#undef LA_PUT_ST
}

__device__ __forceinline__ int la_pair_item(int p, int h2) {
    if (p < 128) { const int q = 2 * p + h2, sc = q & 15, vh = (q >> 4) & 7, b = q >> 7; return sc + 16 * (vh + 16 * b); }
    const int u = p - 128, sc = u & 15, j = (u >> 4) & 3, b = u >> 6; return sc + 16 * (8 + 2 * j + h2 + 16 * b);
}

#define XB_TMO      128
#define XB_XCNT(j)  (256  + 64 * (j))
#define XB_XSUB(j)  (1280 + 64 * (j))
#define XB_XGEN(j)  (2304 + 64 * (j))
#define XB_TOP      3328
#define XB_TOPGEN   3392
#define XCD_BAR_WORDS 3456
#define XB_SPIN_CAP (1u << 18)
__device__ __forceinline__ unsigned xb_ld(unsigned* p)              { return __hip_atomic_load(p, __ATOMIC_RELAXED, __HIP_MEMORY_SCOPE_AGENT); }
__device__ __forceinline__ unsigned xb_add(unsigned* p, unsigned v) { return __hip_atomic_fetch_add(p, v, __ATOMIC_RELAXED, __HIP_MEMORY_SCOPE_AGENT); }
__device__ __forceinline__ unsigned xb_xcc_id() { return (unsigned)__builtin_amdgcn_s_getreg((3 << 11) | 20) & 0xFu; }
#define XB_SPIN(cond, bar) do { unsigned _sp = 0; while (cond) { __builtin_amdgcn_s_sleep(1); \
    if ((++_sp & 255u) == 0u) { if (xb_ld(&(bar)[XB_TMO])) break; if (_sp > XB_SPIN_CAP) { atomicAdd(&(bar)[XB_TMO], 1u); break; } } } } while (0)
struct XcdBarrier { unsigned* bar; unsigned x; volatile LAS unsigned* st; };
__device__ __forceinline__ XcdBarrier xcd_barrier_post(unsigned* bar, volatile LAS unsigned* st) {
    XcdBarrier b; b.bar = bar; b.x = xb_xcc_id(); b.st = st;
    if (threadIdx.x == 0) (void)xb_add(&bar[XB_XCNT(b.x)], 1u);
    return b;
}
__device__ __forceinline__ void xcd_barrier_complete(unsigned* bar, unsigned x, unsigned& nloc, unsigned& nx) {
    const unsigned G = gridDim.x * gridDim.y * gridDim.z;
    unsigned sum, cnt, mine, sp = 0u;
    for (;;) {
        sum = 0u; cnt = 0u; mine = 0u;
#pragma unroll
        for (unsigned j = 0; j < 16; ++j) { const unsigned c = xb_ld(&bar[XB_XCNT(j)]); sum += c; cnt += (c > 0u) ? 1u : 0u; mine = (j == x) ? c : mine; }
        if (sum == G) break;
        __builtin_amdgcn_s_sleep(1);
        if ((++sp & 255u) == 0u) { if (xb_ld(&bar[XB_TMO])) break; if (sp > XB_SPIN_CAP) { atomicAdd(&bar[XB_TMO], 1u); break; } }
    }
    nloc = mine > 0u ? mine : 1u; nx = cnt > 0u ? cnt : 1u;
}
__device__ __forceinline__ void xcd_barrier(const XcdBarrier& b) {
    asm volatile("s_waitcnt vmcnt(0)" ::: "memory");
    __syncthreads();
    if (threadIdx.x == 0) {
        unsigned* bar = b.bar;
        __builtin_amdgcn_s_waitcnt(0);
        unsigned nloc = b.st[0], nx = b.st[1];
        if (nloc == 0u) { xcd_barrier_complete(bar, b.x, nloc, nx); b.st[0] = nloc; b.st[1] = nx; }
        const unsigned old = xb_add(&bar[XB_XSUB(b.x)], 1u);
        const unsigned gen = old / nloc;
        if (old + 1u == (gen + 1u) * nloc) {
            __builtin_amdgcn_fence(__ATOMIC_RELEASE, "agent");
            asm volatile("s_waitcnt vmcnt(0)" ::: "memory");
            const unsigned og = xb_add(&bar[XB_TOP], 1u);
            const unsigned tg = og / nx;
            if (og + 1u == (tg + 1u) * nx) xb_add(&bar[XB_TOPGEN], 1u);
            else XB_SPIN(xb_ld(&bar[XB_TOPGEN]) == tg, bar);
            __builtin_amdgcn_fence(__ATOMIC_ACQUIRE, "agent");
            xb_add(&bar[XB_XGEN(b.x)], 1u);
            asm volatile("s_waitcnt vmcnt(0)" ::: "memory");
        } else {
            XB_SPIN(xb_ld(&bar[XB_XGEN(b.x)]) == gen, bar);
            __builtin_amdgcn_fence(__ATOMIC_ACQUIRE, "agent");
            asm volatile("s_waitcnt vmcnt(0)" ::: "memory");
        }
    }
    __syncthreads();
}

struct Args { const float* x; const float* c; const float* ada_w; const float* ada_b; const float* norm_w; const float* w_in; const float* lb_logits; const float* hnw;
              const float* alpha_w; const float* alpha_b; const float* gnw; const float* w_branch; const float* w_out; const float* fnw; float* out; unsigned char* ws; };

#ifndef PROBE_MASK
#define PROBE_MASK 0
#endif
#ifndef PROBE_LA
#define PROBE_LA 0
#endif
#define PH_END(id) do { { XcdBarrier xb_; xb_.bar = (unsigned*)(ws + WS_BAR); xb_.x = xb_xcc_id(); xb_.st = (volatile LAS unsigned*)(lds + L_BARST); xcd_barrier(xb_); } if (PROBE_MASK) { const unsigned long long now_ = __builtin_amdgcn_s_memrealtime(); if ((PROBE_MASK >> (id)) & 1) tacc += now_ - tprev; tprev = now_; } } while (0)
__global__ void __launch_bounds__(512, 2) fwd_megakernel(Args a) {
    extern __shared__ __attribute__((aligned(16))) unsigned char lds_raw[];
    LAS unsigned char* lds = (LAS unsigned char*)lds_raw;
    cg::grid_group grid = cg::this_grid();
    const int tid = threadIdx.x, lane = tid & 63, wave = __builtin_amdgcn_readfirstlane(tid >> 6);
    const int G = gridDim.x, bid = blockIdx.x;
    const int gw = bid * 8 + wave, NGW = G * 8;
    unsigned char* ws = a.ws;
    if (gridDim.y == 0x7fffu) grid.sync();
    if (tid < 2) *(volatile LAS unsigned*)(lds + L_BARST + 4 * tid) = 0u;
    __syncthreads();
    (void)xcd_barrier_post((unsigned*)(ws + WS_BAR), (volatile LAS unsigned*)(lds + L_BARST));
    unsigned long long tacc = 0ull, tprev = (PROBE_MASK || PROBE_LA) ? __builtin_amdgcn_s_memrealtime() : 0ull;
    float* mod = (float*)(ws + WS_MOD); float* lbv = (float*)(ws + WS_LB); float* SS = (float*)(ws + WS_SS); float* DSC = (float*)(ws + WS_DSC);
    bf16_t* D1 = (bf16_t*)(ws + WS_D1); bf16_t* P = (bf16_t*)(ws + WS_P);
    bf16_t* H = (bf16_t*)((unsigned char*)a.out + OUT_H); float* ST = (float*)((unsigned char*)a.out + OUT_ST);

    for (int jb = bid; jb < 192; jb += G) {
        LAS float* cact = (LAS float*)lds; LAS float* red = cact + 2048;
        for (int i = tid; i < 2048; i += 512) { const float v = a.c[i]; cact[i] = v * fsigmoid(v); }
        __syncthreads();
        const int l = jb / 96, j0 = (jb % 96) * 32, jj = tid & 31, seg = tid >> 5;
        const float* wp = a.ada_w + (size_t)l * 1024 * 3072 + j0 + jj;
        float a0 = 0.f, a1 = 0.f;
        float wv[64];
#pragma unroll
        for (int i = 0; i < 64; ++i) wv[i] = wp[(size_t)(seg * 64 + i) * 3072];
#pragma unroll
        for (int i = 0; i < 64; ++i) { a0 += cact[seg * 64 + i] * wv[i]; a1 += cact[1024 + seg * 64 + i] * wv[i]; }
        red[(seg * 32 + jj) * 2] = a0; red[(seg * 32 + jj) * 2 + 1] = a1;
        __syncthreads();
        if (tid < 64) { const int j2 = tid & 31, b = tid >> 5; float s = 0.f;
#pragma unroll
            for (int sg = 0; sg < 16; ++sg) s += red[(sg * 32 + j2) * 2 + b];
            mod[(l * 2 + b) * 3072 + j0 + j2] = s + a.ada_b[l * 3072 + j0 + j2]; }
        __syncthreads();
    }
    for (int j = bid * 512 + tid; j < 1024; j += G * 512) {
        const float l0 = a.lb_logits[j], l1 = a.lb_logits[1024 + j], mx = fmaxf(l0, l1), e0 = __expf(l0 - mx), e1 = __expf(l1 - mx);
        const float p0 = e0 / (e0 + e1), p1 = e1 / (e0 + e1);
        lbv[j] = 0.f; lbv[1024 + j] = fminf(fmaxf((p0 + p1) - p0, 0.f), 1.f);
    }
    {
        LAS float* scr = (LAS float*)(lds + wave * 8448);
        for (int it = gw; it < 2 * 6400; it += NGW) {
            const int l = it / 6400; int r = it % 6400;
            bf16_t* WT = (bf16_t*)(ws + WS_W + (size_t)l * W_LAYER);
            const float* win = a.w_in + (size_t)l * 1024 * DIN;
            if (r < 1536) { tr_item(win, DIN, 0, WT, 0, scr, r, 96, lane); continue; } r -= 1536;
            if (r < 1024) { tr_item(win, DIN, 4096, WT, 3072, scr, r, 64, lane); continue; } r -= 1024;
            if (r < 256) { tr_item_la(win, a.alpha_w + (size_t)l * 16 * 512, WT, 5120, scr, r, lane); continue; } r -= 256;
            if (r < 512) { tr_item(win, DIN, 3072, WT, 5632, scr, r, 32, lane); continue; } r -= 512;
            if (r < 512) { tr_item(win, DIN, 6144, WT, 6656, scr, r, 32, lane); continue; } r -= 512;
            if (r < 1024) { tr_item(win, DIN, 7184, WT, 7680, scr, r, 64, lane); continue; } r -= 1024;
            if (r < 512) { tr_item(a.w_branch + (size_t)l * 2 * 1048576, 1024, 0, WT, 9728, scr, r, 32, lane); continue; } r -= 512;
            if (r < 512) { tr_item(a.w_branch + (size_t)l * 2 * 1048576 + 1048576, 1024, 0, WT, 10752, scr, r, 32, lane); continue; } r -= 512;
            tr_item(a.w_out + (size_t)l * 1048576, 1024, 0, WT, 11776, scr, r, 32, lane);
        }
    }
    PH_END(0);

#pragma unroll 1
    for (int l = 0; l < 2; ++l) {
        const bf16_t* WT = (const bf16_t*)(ws + WS_W + (size_t)l * W_LAYER);
        const float* modl = mod + l * 2 * 3072;
        { const int tid = opaque_tid(), lane = tid & 63, wave = __builtin_amdgcn_readfirstlane(tid >> 6), gw = bid * 8 + wave;
        for (int i = bid * 512 + tid; i < MROWS * 8; i += G * 512) SS[i] = 0.f;
        const float* nw = a.norm_w + l * 1024;
        for (int m0 = gw; m0 < MROWS; m0 += 4 * NGW) {
            const int b = m0 >> 13;
            const float* mb = modl + b * 3072;
            f32x4 av[4], sv[4];
#pragma unroll
            for (int j = 0; j < 4; ++j) { const int col = 4 * lane + 256 * j; av[j] = *(const f32x4*)(nw + col) * (*(const f32x4*)(mb + 1024 + col) + 1.f); sv[j] = *(const f32x4*)(mb + col); }
            f32x4 v[4][4];
#pragma unroll
            for (int r = 0; r < 4; ++r) { const f32x4* xr = (const f32x4*)(a.x + (size_t)(m0 + r * NGW) * DM) + lane;
#pragma unroll
                for (int j = 0; j < 4; ++j) v[r][j] = xr[64 * j]; }
            if (l == 1) {
#pragma unroll
                for (int r = 0; r < 4; ++r) { const u32x2* dr = (const u32x2*)(D1 + (size_t)(m0 + r * NGW) * DM) + lane;
#pragma unroll
                    for (int j = 0; j < 4; ++j) { const u32x2 d = dr[64 * j]; v[r][j][0] += bf_lo(d.x); v[r][j][1] += bf_hi(d.x); v[r][j][2] += bf_lo(d.y); v[r][j][3] += bf_hi(d.y); } } }
#pragma unroll
            for (int r = 0; r < 4; ++r) {
                float s = 0.f;
#pragma unroll
                for (int j = 0; j < 4; ++j) s += (v[r][j][0] * v[r][j][0] + v[r][j][1] * v[r][j][1]) + (v[r][j][2] * v[r][j][2] + v[r][j][3] * v[r][j][3]);
                const float rstd = rsqrtf(wave_sum(s) * (1.f / 1024.f) + EPS);
                u32x2* hr = (u32x2*)(H + (size_t)(m0 + r * NGW) * DM) + lane;
#pragma unroll
                for (int j = 0; j < 4; ++j) { const f32x4 h = v[r][j] * rstd * av[j] + sv[j];
                    u32x2 o; o.x = cvt_pk_bf16(h[0], h[1]); o.y = cvt_pk_bf16(h[2], h[3]); hr[64 * j] = o; }
            }
        } }
        PH_END(1);
        { pg8::Gemm g{H, WT, 1024, 1024}; pg8::StaticOrder S; S.init(MROWS, 5632, G, bid);
          EpiA1 E{P, lbv + l * 1024, a.alpha_b + l * 512};
          pg8::gemm_phase<EpiA1, pg8::StaticOrder>(lds, g, S, E); }
        PH_END(2);
        for (int p = bid; p < 256; p += G)
            for (int h2 = 0; h2 < 2; ++h2) la_item<false>(lds, P, ST, DSC, SS, la_pair_item(p, h2), tacc, tprev);
        PH_END(3);
        for (int gt = bid * 512 + opaque_tid(); gt < 32 * 4096; gt += G * 512) {
            const int chain = gt >> 12, e = gt & 4095, k = e >> 5;
            f32x4* p0 = (f32x4*)(ST + (size_t)chain * 16 * 16384) + e; const float* d0 = DSC + (size_t)chain * 16 * 128 + k;
            f32x4 cur[15]; float dd[15];
#pragma unroll
            for (int sc = 0; sc < 15; ++sc) { cur[sc] = p0[(size_t)sc * 4096]; dd[sc] = d0[sc * 128]; }
            f32x4 carry = (f32x4){0.f, 0.f, 0.f, 0.f};
#pragma unroll
            for (int sc = 0; sc < 16; ++sc) { p0[(size_t)sc * 4096] = carry; if (sc < 15) carry = carry * dd[sc] + cur[sc]; }
        }
        PH_END(4);
        for (int p = bid; p < 256; p += G)
            for (int h2 = 0; h2 < 2; ++h2) la_item<true>(lds, P, ST, DSC, SS, la_pair_item(p, h2), tacc, tprev);
        PH_END(5);
        { pg8::Gemm g{H, WT + (size_t)5632 * 1024, 1024, 1024}; pg8::StaticOrder S; S.init(MROWS, 4096, G, bid);
          EpiA2 E{P, SS, a.hnw + l * 1024, a.gnw + l * 256};
          pg8::gemm_phase<EpiA2, pg8::StaticOrder>(lds, g, S, E); }
        PH_END(6);
        { pg8::Gemm g{P, WT + (size_t)9728 * 1024, LDP, 1024}; pg8::BranchOrder S; S.s.init(MROWS, 1024, G, bid);
          EpiC1 E{P};
          pg8::gemm_phase<EpiC1, pg8::BranchOrder>(lds, g, S, E); }
        PH_END(7);
        { pg8::Gemm g{P + 3072, WT + (size_t)11776 * 1024, LDP, 1024}; pg8::StaticOrder S; S.init(MROWS, 1024, G, bid);
          if (l == 0) { EpiC2a E{D1, modl}; pg8::gemm_phase<EpiC2a, pg8::StaticOrder>(lds, g, S, E); }
          else { EpiC2b E{a.x, D1, a.out, modl}; pg8::gemm_phase<EpiC2b, pg8::StaticOrder>(lds, g, S, E); } }
        PH_END(8);
    }
    {
        f32x4 nv[4];
#pragma unroll
        for (int j = 0; j < 4; ++j) nv[j] = *(const f32x4*)(a.fnw + 4 * lane + 256 * j);
        for (int m0 = gw; m0 < MROWS; m0 += 4 * NGW) {
            f32x4 v[4][4];
#pragma unroll
            for (int r = 0; r < 4; ++r) { const f32x4* xr = (const f32x4*)(a.out + (size_t)(m0 + r * NGW) * DM) + lane;
#pragma unroll
                for (int j = 0; j < 4; ++j) v[r][j] = xr[64 * j]; }
#pragma unroll
            for (int r = 0; r < 4; ++r) {
                float s = 0.f;
#pragma unroll
                for (int j = 0; j < 4; ++j) s += (v[r][j][0] * v[r][j][0] + v[r][j][1] * v[r][j][1]) + (v[r][j][2] * v[r][j][2] + v[r][j][3] * v[r][j][3]);
                const float rstd = rsqrtf(wave_sum(s) * (1.f / 1024.f) + EPS);
                f32x4* xw = (f32x4*)(a.out + (size_t)(m0 + r * NGW) * DM) + lane;
#pragma unroll
                for (int j = 0; j < 4; ++j) xw[64 * j] = v[r][j] * rstd * nv[j];
            }
        }
    }
    if (PROBE_MASK || PROBE_LA) { if ((PROBE_MASK >> 9) & 1) tacc += __builtin_amdgcn_s_memrealtime() - tprev;
        if (bid == 0 && threadIdx.x == 0) { const unsigned long long t0 = __builtin_amdgcn_s_memrealtime(); while (__builtin_amdgcn_s_memrealtime() - t0 < 4ull * tacc) __builtin_amdgcn_s_sleep(32); } }
}

extern "C" void kernel_launch(void* const* d_in, const int* in_sizes, int n_in, void* d_out, int out_size, void* d_ws, size_t ws_size, hipStream_t stream) {
    static int grid = 0;
    if (grid == 0) {
        if (n_in != 14 || out_size != MROWS * DM || ws_size < WS_END) { fprintf(stderr, "kernel_launch: unexpected problem (n_in %d, out %d, ws %zu < %zu)\n", n_in, out_size, ws_size, (size_t)WS_END); grid = -1; return; }
        int dev = 0, cus = 0, per_cu = 0;
        if (hipGetDevice(&dev) != hipSuccess || hipDeviceGetAttribute(&cus, hipDeviceAttributeMultiprocessorCount, dev) != hipSuccess) { grid = -1; return; }
        if (hipFuncSetAttribute((const void*)fwd_megakernel, hipFuncAttributeMaxDynamicSharedMemorySize, LDS_BYTES) != hipSuccess) { fprintf(stderr, "kernel_launch: hipFuncSetAttribute failed\n"); grid = -1; return; }
        if (hipOccupancyMaxActiveBlocksPerMultiprocessor(&per_cu, (const void*)fwd_megakernel, 512, LDS_BYTES) != hipSuccess || per_cu < 1) { fprintf(stderr, "kernel_launch: occupancy query says %d\n", per_cu); grid = -1; return; }
        if (cus != 256) { fprintf(stderr, "kernel_launch: built for a 256-CU device (got %d)\n", cus); grid = -1; return; }
        grid = cus;
    }
    if (grid < 0) return;
    Args a{};
    a.x = (const float*)d_in[0]; a.c = (const float*)d_in[1]; a.ada_w = (const float*)d_in[2]; a.ada_b = (const float*)d_in[3]; a.norm_w = (const float*)d_in[4]; a.w_in = (const float*)d_in[5];
    a.lb_logits = (const float*)d_in[6]; a.hnw = (const float*)d_in[7]; a.alpha_w = (const float*)d_in[8]; a.alpha_b = (const float*)d_in[9]; a.gnw = (const float*)d_in[10];
    a.w_branch = (const float*)d_in[11]; a.w_out = (const float*)d_in[12]; a.fnw = (const float*)d_in[13]; a.out = (float*)d_out; a.ws = (unsigned char*)d_ws;
    if (hipMemsetAsync((char*)d_ws + WS_BAR, 0, XCD_BAR_WORDS * 4, stream) != hipSuccess) { fprintf(stderr, "kernel_launch: memset failed\n"); return; }
    void* args[] = {&a};
    const hipError_t e = hipLaunchCooperativeKernel((const void*)fwd_megakernel, dim3(grid), dim3(512), args, LDS_BYTES, stream);
    if (e != hipSuccess) fprintf(stderr, "kernel_launch: cooperative launch failed: %s (grid %d)\n", hipGetErrorString(e), grid);
}
```
